# Optimizing an MI355X kernel written in HIP

```python
import jax, jax.numpy as jnp
from jax import lax
import numpy as np

D_MODEL = 4096
BATCH = 1
SEQ = 8192
DEPTH = 2

HEAD_DIM = 128
MIX_WIDTH = D_MODEL
N_MIXERS = 4
HEADS_PER_MIXER = MIX_WIDTH // (N_MIXERS * HEAD_DIM)
GROUP_WIDTH = HEADS_PER_MIXER * HEAD_DIM
Q_LORA_RANK = 896
KV_LORA_RANK = 512
MLA_NOPE_DIM = 128
MLA_ROPE_DIM = 64
ROPE_THETA = 500000.0
PARTIAL_ROPE_DIM = HEAD_DIM // 4
DILATED_PAIRS = ((128, 1), (512, 4), (2048, 16))
Q_BLOCK = 128
DIL_ALIGN = max(d for _, d in DILATED_PAIRS) * Q_BLOCK
D_FF = 4 * D_MODEL
EPS = 1e-6
NEG_INF = -1e30

IN_SIZES = (Q_LORA_RANK, KV_LORA_RANK, MLA_ROPE_DIM,
            3 * GROUP_WIDTH, 3 * GROUP_WIDTH, 3 * GROUP_WIDTH, HEADS_PER_MIXER)
IN_COLS = sum(IN_SIZES)
SPLIT_POINTS = tuple(int(v) for v in np.cumsum(IN_SIZES)[:-1])

kernel_name = "hymba_mla_dilated_stickbreak_fox_trunk"


def rmsnorm(x, g):
    x32 = x.astype(jnp.float32)
    y = x32 * lax.rsqrt(jnp.mean(x32 * x32, axis=-1, keepdims=True) + EPS)
    return (y * g.astype(jnp.float32)).astype(x.dtype)


def rope(t, pos):
    r = t.shape[-1]
    half = r // 2
    inv = ROPE_THETA ** (-jnp.arange(half, dtype=jnp.float32) * (2.0 / r))
    ang = pos.astype(jnp.float32)[:, None] * inv[None, :]
    cos = jnp.cos(ang)[:, None, :]
    sin = jnp.sin(ang)[:, None, :]
    t32 = t.astype(jnp.float32)
    t1, t2 = t32[..., :half], t32[..., half:]
    return jnp.concatenate([t1 * cos - t2 * sin, t1 * sin + t2 * cos], axis=-1).astype(t.dtype)


def partial_rope(t, pos):
    return jnp.concatenate([rope(t[..., :PARTIAL_ROPE_DIM], pos), t[..., PARTIAL_ROPE_DIM:]], axis=-1)


def to_blocks(t):
    b, s, h, d = t.shape
    return t.reshape(b, s // Q_BLOCK, Q_BLOCK, h, d).transpose(1, 0, 2, 3, 4)


def from_blocks(t):
    nb, b, q, h, d = t.shape
    return t.transpose(1, 0, 2, 3, 4).reshape(b, nb * q, h, d)


def mla_attention(q_nope, q_rope, k_nope, k_rope, v):
    s_len = k_nope.shape[1]
    kpos = jnp.arange(s_len)
    scale = (MLA_NOPE_DIM + MLA_ROPE_DIM) ** -0.5

    def blk(args):
        qn, qr, i = args
        s = (jnp.einsum('bqhd,bkhd->bhqk', qn, k_nope)
             + jnp.einsum('bqhd,bkd->bhqk', qr, k_rope)).astype(jnp.float32) * scale
        qpos = i * Q_BLOCK + jnp.arange(Q_BLOCK)
        s = jnp.where(kpos[None, :] <= qpos[:, None], s, NEG_INF)
        p = jax.nn.softmax(s, axis=-1)
        return jnp.einsum('bhqk,bkhd->bqhd', p, v)

    nb = s_len // Q_BLOCK
    out = lax.map(blk, (to_blocks(q_nope), to_blocks(q_rope), jnp.arange(nb)))
    return from_blocks(out)


def dilated_branch(q, k, v, window, dil):
    b, sp, h, d = q.shape
    sub_len = sp // dil
    nb = sub_len // Q_BLOCK
    band = window // dil
    scale = HEAD_DIM ** -0.5

    def to_sub(t):
        return t.reshape(b, sub_len, dil, h, d).transpose(0, 2, 1, 3, 4).reshape(b * dil, nb, Q_BLOCK, h, d)

    def with_prev(t):
        prev = jnp.pad(t[:, :-1], ((0, 0), (1, 0), (0, 0), (0, 0), (0, 0)))
        return jnp.concatenate([prev, t], axis=2)

    qs = to_sub(q)
    kb = with_prev(to_sub(k))
    vb = with_prev(to_sub(v))
    s = jnp.einsum('bnqhd,bnkhd->bnhqk', qs, kb).astype(jnp.float32) * scale
    i = jnp.arange(Q_BLOCK)[:, None]
    j = jnp.arange(2 * Q_BLOCK)[None, :]
    n = jnp.arange(nb)[:, None, None]
    dist = Q_BLOCK + i - j
    valid = (dist >= 0) & (dist <= band) & ((n > 0) | (j >= Q_BLOCK))
    s = jnp.where(valid[None, :, None], s, NEG_INF)
    m = jnp.max(s, axis=-1, keepdims=True)
    p = jnp.exp(s - m)
    l = jnp.sum(p, axis=-1, keepdims=True)
    o = jnp.einsum('bnhqk,bnkhd->bnhqd', p, vb) / l
    lse = (m + jnp.log(l))[..., 0]
    o = o.transpose(0, 1, 3, 2, 4).reshape(b, dil, sub_len, h, d).transpose(0, 2, 1, 3, 4).reshape(b, sp, h, d)
    lse = lse.transpose(0, 1, 3, 2).reshape(b, dil, sub_len, h).transpose(0, 2, 1, 3).reshape(b, sp, h)
    return o, lse


def dilated_attention(q, k, v):
    s_len = q.shape[1]
    sp = -(-s_len // DIL_ALIGN) * DIL_ALIGN
    padw = ((0, 0), (0, sp - s_len), (0, 0), (0, 0))
    qp, kp, vp = jnp.pad(q, padw), jnp.pad(k, padw), jnp.pad(v, padw)
    outs, lses = [], []
    for window, dil in DILATED_PAIRS:
        o, lse = dilated_branch(qp, kp, vp, window, dil)
        outs.append(o)
        lses.append(lse)
    w = jax.nn.softmax(jnp.stack(lses, axis=0), axis=0)
    o = jnp.sum(w[..., None] * jnp.stack(outs, axis=0), axis=0)
    return o[:, :s_len]


def stick_breaking_attention(q, k, v):
    s_len = k.shape[1]
    kpos = jnp.arange(s_len)
    scale = HEAD_DIM ** -0.5

    def blk(args):
        qb, i = args
        z = jnp.einsum('bqhd,bkhd->bhqk', qb, k).astype(jnp.float32) * scale
        qpos = i * Q_BLOCK + jnp.arange(Q_BLOCK)
        mask = kpos[None, :] < qpos[:, None]
        log_1m = jnp.where(mask, jax.nn.log_sigmoid(-z), 0.0)
        after = lax.cumsum(log_1m, axis=3, reverse=True) - log_1m
        a = jnp.where(mask, jnp.exp(jax.nn.log_sigmoid(z) + after), 0.0)
        return jnp.einsum('bhqk,bkhd->bqhd', a, v)

    nb = s_len // Q_BLOCK
    return from_blocks(lax.map(blk, (to_blocks(q), jnp.arange(nb))))


def forgetting_attention(q, k, v, logf_cum):
    b, s_len, h, _ = k.shape
    kpos = jnp.arange(s_len)
    scale = HEAD_DIM ** -0.5
    nb = s_len // Q_BLOCK
    ck = jnp.transpose(logf_cum, (0, 2, 1))[:, :, None, :]
    cq = logf_cum.reshape(b, nb, Q_BLOCK, h).transpose(1, 0, 3, 2)

    def blk(args):
        qb, cqb, i = args
        s = jnp.einsum('bqhd,bkhd->bhqk', qb, k).astype(jnp.float32) * scale + (cqb[..., None] - ck)
        qpos = i * Q_BLOCK + jnp.arange(Q_BLOCK)
        s = jnp.where(kpos[None, :] <= qpos[:, None], s, NEG_INF)
        p = jax.nn.softmax(s, axis=-1)
        return jnp.einsum('bhqk,bkhd->bqhd', p, v)

    return from_blocks(lax.map(blk, (to_blocks(q), cq, jnp.arange(nb))))


def setup_inputs(seed: int = 0) -> dict:
    key = jax.random.key(seed)
    ks = jax.random.split(key, 16)
    f32 = jnp.float32

    def nrm(k, shape, fan_in):
        return jax.random.normal(k, shape, f32) * (fan_in ** -0.5)

    def gain(k, shape):
        return 1.0 + 0.05 * jax.random.normal(k, shape, f32)

    return {
        "x": jax.random.normal(ks[0], (BATCH, SEQ, D_MODEL), f32),
        "g_attn": gain(ks[1], (DEPTH, D_MODEL)),
        "w_in": nrm(ks[2], (DEPTH, D_MODEL, IN_COLS), D_MODEL),
        "g_q": gain(ks[3], (DEPTH, Q_LORA_RANK)),
        "g_kv": gain(ks[4], (DEPTH, KV_LORA_RANK)),
        "w_uq": nrm(ks[5], (DEPTH, Q_LORA_RANK, HEADS_PER_MIXER * (MLA_NOPE_DIM + MLA_ROPE_DIM)), Q_LORA_RANK),
        "w_uk": nrm(ks[6], (DEPTH, KV_LORA_RANK, HEADS_PER_MIXER * MLA_NOPE_DIM), KV_LORA_RANK),
        "w_uv": nrm(ks[7], (DEPTH, KV_LORA_RANK, GROUP_WIDTH), KV_LORA_RANK),
        "b_f": jax.random.uniform(ks[8], (DEPTH, HEADS_PER_MIXER), f32, minval=1.0, maxval=5.0),
        "g_out": gain(ks[9], (DEPTH, MIX_WIDTH)),
        "w_o": nrm(ks[10], (DEPTH, MIX_WIDTH, D_MODEL), MIX_WIDTH),
        "g_mlp": gain(ks[11], (DEPTH, D_MODEL)),
        "w_up": nrm(ks[12], (DEPTH, D_MODEL, D_FF), D_MODEL),
        "w_down": nrm(ks[13], (DEPTH, D_FF, D_MODEL), D_FF),
        "g_final": gain(ks[14], (D_MODEL,)),
    }


def reference(x, g_attn, w_in, g_q, g_kv, w_uq, w_uk, w_uv, b_f, g_out, w_o, g_mlp, w_up, w_down, g_final):
    b, s_len, _ = x.shape
    pos = jnp.arange(s_len)

    def heads(t, d=HEAD_DIM):
        return t.reshape(b, s_len, -1, d)

    for l in range(DEPTH):
        h = rmsnorm(x, g_attn[l])
        proj = h @ w_in[l]
        p_cq, p_ckv, p_kr, p_b, p_c, p_d, p_f = jnp.split(proj, SPLIT_POINTS, axis=-1)

        qa = heads(rmsnorm(p_cq, g_q[l]) @ w_uq[l], MLA_NOPE_DIM + MLA_ROPE_DIM)
        q_nope = qa[..., :MLA_NOPE_DIM]
        q_rope = rope(qa[..., MLA_NOPE_DIM:], pos)
        c_kv = rmsnorm(p_ckv, g_kv[l])
        k_nope = heads(c_kv @ w_uk[l], MLA_NOPE_DIM)
        v_a = heads(c_kv @ w_uv[l])
        k_rope = rope(p_kr[:, :, None, :], pos)[:, :, 0, :]
        o_a = mla_attention(q_nope, q_rope, k_nope, k_rope, v_a)

        qb, kb, vb = jnp.split(p_b, 3, axis=-1)
        o_b = dilated_attention(partial_rope(heads(qb), pos), partial_rope(heads(kb), pos), heads(vb))

        qc, kc, vc = jnp.split(p_c, 3, axis=-1)
        o_c = stick_breaking_attention(heads(qc), heads(kc), heads(vc))

        qd, kd, vd = jnp.split(p_d, 3, axis=-1)
        logf = jax.nn.log_sigmoid(p_f.astype(jnp.float32) + b_f[l].astype(jnp.float32))
        o_d = forgetting_attention(heads(qd), heads(kd), heads(vd), jnp.cumsum(logf, axis=1))

        groups = []
        for gi, o in enumerate((o_a, o_b, o_c, o_d)):
            o = o.reshape(b, s_len, GROUP_WIDTH).astype(x.dtype)
            groups.append(rmsnorm(o, g_out[l, gi * GROUP_WIDTH:(gi + 1) * GROUP_WIDTH]))
        x = x + jnp.concatenate(groups, axis=-1) @ w_o[l]

        h = rmsnorm(x, g_mlp[l])
        x = x + jnp.square(jax.nn.relu(h @ w_up[l])) @ w_down[l]

    return rmsnorm(x, g_final)
```

```cpp
#include <hip/hip_runtime.h>
#include <cstdio>
#include <cstdint>
namespace pg8 {
#define PG8_LAS __attribute__((address_space(3)))
typedef unsigned short bf16_t;
typedef short bf16x8 __attribute__((ext_vector_type(8)));
typedef float f32x4 __attribute__((ext_vector_type(4)));
typedef unsigned u32x4 __attribute__((ext_vector_type(4)));
constexpr int BM = 256, BK = 64, HALF = 128, HTB = HALF * BK * 2  , STAGE_BYTES = 8 * HTB, NXCD = 8, WGM = 8;

__host__ __device__ __forceinline__ int lds_byte(int r, int c) { const int st = (r >> 4) * 2 + (c >> 5), rr = r & 15, cc = c & 31, ob = rr * 64 + cc * 2; return st * 1024 + (ob ^ (((ob >> 9) & 1) << 5)); }
__host__ __device__ __forceinline__ void stage_rc(int b, int& R, int& C) { const int st = b / 1024, sb = b % 1024, swz = sb ^ (((sb >> 9) & 1) << 5); R = (st >> 1) * 16 + swz / 64; C = (st & 1) * 32 + (swz % 64) / 2; }
__host__ __device__ __forceinline__ int perm32(int rho) { const int n = rho >> 4, i = rho & 15; return 8 * (i >> 2) + 4 * n + (i & 3); }

struct Unit { int pm, pn; };
struct Gemm { const bf16_t* A; const bf16_t* Bt; int M, N, K; };

struct StaticOrder {
    int nM, nN, nwg, G, c;
    __host__ __device__ void init(int M, int N, int G_, int c_) { nM = M / BM; nN = N / BM; nwg = nM * nN; G = G_; c = c_; }
    __host__ __device__ bool next(int i, Unit& u) const {
        const long L = (long)i * G + c; if (L >= nwg) return false;
        int wgid = (int)L; { const int q = nwg / NXCD, r = nwg % NXCD, xcd = wgid % NXCD, off = wgid / NXCD; wgid = (xcd < r ? xcd * (q + 1) : r * (q + 1) + (xcd - r) * q) + off; }
        const int nig = WGM * nN, gid = wgid / nig, fm = gid * WGM, gsz = (nM - fm) < WGM ? (nM - fm) : WGM;
        u.pm = fm + ((wgid % nig) % gsz); u.pn = (wgid % nig) / gsz; return true;
    }
    __device__ __forceinline__ void a_ready(const Unit&) const {}
    __device__ __forceinline__ void done(const Unit&) const {}
};

__device__ __forceinline__ unsigned cvt_pk_bf16(float lo, float hi) { unsigned r; asm volatile("v_cvt_pk_bf16_f32 %0, %1, %2" : "=v"(r) : "v"(lo), "v"(hi)); return r; }
template <int ACT> struct EpiBf16 {
    static constexpr bool PERM = true, AFTER_DRAIN = false;
    bf16_t* O; int ldc; float* side; int side_col;
    __device__ __forceinline__ void operator()(const f32x4 (&acc)[2][2][4][2], const Unit& u, int wr, int wc, int fr, int fq) const {
        const int row0 = u.pm * BM + wr * 64 + fr; const int col0 = u.pn * BM + wc * 32 + 8 * fq;
#pragma unroll
        for (int ai = 0; ai < 2; ++ai)
#pragma unroll
            for (int m = 0; m < 4; ++m) { const int row = row0 + ai * HALF + m * 16; bf16_t* rowp = O + (size_t)row * ldc + col0;
#pragma unroll
                for (int bj = 0; bj < 2; ++bj) { f32x4 v0 = acc[ai][bj][m][0], v1 = acc[ai][bj][m][1];
                    if (side != nullptr && col0 + bj * HALF == side_col) { *(f32x4*)(side + (size_t)row * 8) = v0; *(f32x4*)(side + (size_t)row * 8 + 4) = v1; }
                    if (ACT == 2) {
#pragma unroll
                        for (int e = 0; e < 4; ++e) { const float a = fmaxf(v0[e], 0.f), b = fmaxf(v1[e], 0.f); v0[e] = a * a; v1[e] = b * b; } }
                    u32x4 w; w.x = cvt_pk_bf16(v0[0], v0[1]); w.y = cvt_pk_bf16(v0[2], v0[3]); w.z = cvt_pk_bf16(v1[0], v1[1]); w.w = cvt_pk_bf16(v1[2], v1[3]);
                    *(u32x4*)(rowp + bj * HALF) = w; } }
    }
};
struct EpiResid {
    static constexpr bool PERM = true, AFTER_DRAIN = false;
    const float* R; float* O; int ldc;
    __device__ __forceinline__ void operator()(const f32x4 (&acc)[2][2][4][2], const Unit& u, int wr, int wc, int fr, int fq) const {
        const int row0 = u.pm * BM + wr * 64 + fr; const int col0 = u.pn * BM + wc * 32 + 8 * fq;
#pragma unroll
        for (int ai = 0; ai < 2; ++ai)
#pragma unroll
            for (int m = 0; m < 4; ++m) { const size_t off = (size_t)(row0 + ai * HALF + m * 16) * ldc + col0;
#pragma unroll
                for (int bj = 0; bj < 2; ++bj) { const f32x4 r0 = *(const f32x4*)(R + off + bj * HALF), r1 = *(const f32x4*)(R + off + bj * HALF + 4);
                    *(f32x4*)(O + off + bj * HALF) = r0 + acc[ai][bj][m][0]; *(f32x4*)(O + off + bj * HALF + 4) = r1 + acc[ai][bj][m][1]; } }
    }
};

template <class Epi, class Sched, bool ALIGN_EPI = false, bool SP2 = false>
__device__ __forceinline__ void gemm_phase(PG8_LAS unsigned char* lds, const Gemm g, const Sched& S, const Epi& E) {
    int tid_ = threadIdx.x; asm volatile("" : "+v"(tid_));
    const int tid = tid_, wid = __builtin_amdgcn_readfirstlane(tid >> 6), lane = tid & 63, wr = wid >> 2, wc = wid & 3, fr = lane & 15, fq = lane >> 4;
    const int K = g.K, nt = K / BK;
    unsigned voffA[2], voffB[2];
#pragma unroll
    for (int i = 0; i < 2; ++i) { int R, C; stage_rc(tid * 16 + i * 8192, R, C); const int Rb = Epi::PERM ? ((R & ~31) + perm32(R & 31)) : R;
        voffA[i] = (unsigned)(R * K + C) * 2u; voffB[i] = (unsigned)(Rb * K + C) * 2u; }
    const size_t kstep = (size_t)(BK * 2);
    const size_t hstep = (size_t)HALF * K * 2;
    const size_t tstep = 2 * hstep;
    const unsigned ldsw = (unsigned)wid * 1024u;
    const int aoff = lds_byte(wr * 64 + fr, fq * 8), boff = lds_byte(wc * 32 + fr, fq * 8);
#define PG8_SA(b, h) (((b) * 2 + (h)) * HTB)
#define PG8_SB(b, h) ((4 + (b) * 2 + (h)) * HTB)
#define PG8_STAGE(bufoff, gbase, voff) do { _Pragma("unroll") for (int _i = 0; _i < 2; ++_i) \
        __builtin_amdgcn_global_load_lds((const unsigned*)((const char*)(gbase) + (voff)[_i]), (PG8_LAS unsigned*)(lds + (bufoff) + ldsw + _i * 8192), 16, 0, 0); } while (0)
#define PG8_LDA(dst, b, h) do { _Pragma("unroll") for (int m = 0; m < 4; ++m) _Pragma("unroll") for (int k = 0; k < 2; ++k) dst[m][k] = *(const PG8_LAS bf16x8*)(lds + PG8_SA(b, h) + aoff + m * 2048 + k * 1024); } while (0)
#define PG8_LDB(dst, b, h) do { _Pragma("unroll") for (int n = 0; n < 2; ++n) _Pragma("unroll") for (int k = 0; k < 2; ++k) dst[n][k] = *(const PG8_LAS bf16x8*)(lds + PG8_SB(b, h) + boff + n * 2048 + k * 1024); } while (0)
#define PG8_MMA(ai, bj, At, Bt) do { __builtin_amdgcn_s_setprio(1); _Pragma("unroll") for (int m = 0; m < 4; ++m) _Pragma("unroll") for (int n = 0; n < 2; ++n) _Pragma("unroll") for (int k = 0; k < 2; ++k) \
        acc[ai][bj][m][n] = __builtin_amdgcn_mfma_f32_16x16x32_bf16(Bt[n][k], At[m][k], acc[ai][bj][m][n], 0, 0, 0); __builtin_amdgcn_s_setprio(0); } while (0)
#define PG8_WAIT_V(n) asm volatile("s_waitcnt vmcnt(" #n ")" ::: "memory")
#define PG8_WAIT_L(n) asm volatile("s_waitcnt lgkmcnt(" #n ")" ::: "memory")
#define PG8_BAR __builtin_amdgcn_s_barrier()
#define PG8_SCHED __builtin_amdgcn_sched_barrier(0)
    Unit cur, nxt; int ui = 0;
    if (!S.next(0, cur)) return;
    f32x4 acc[2][2][4][2];
#pragma unroll
    for (int a = 0; a < 2; ++a)
#pragma unroll
        for (int b = 0; b < 2; ++b)
#pragma unroll
            for (int m = 0; m < 4; ++m)
#pragma unroll
                for (int n = 0; n < 2; ++n) acc[a][b][m][n] = (f32x4){0.f, 0.f, 0.f, 0.f};
    bf16x8 At[4][2], B0[2][2], B1[2][2];
    const char* cA = (const char*)g.A + (size_t)cur.pm * tstep; const char* cB = (const char*)g.Bt + (size_t)cur.pn * tstep;
    S.a_ready(cur);
    if constexpr (SP2) {
        PG8_STAGE(PG8_SB(0, 0), cB, voffB); PG8_STAGE(PG8_SB(0, 1), cB + hstep, voffB); PG8_STAGE(PG8_SA(0, 0), cA, voffA); PG8_STAGE(PG8_SA(0, 1), cA + hstep, voffA);
        if (wr == 1) PG8_BAR;
        PG8_WAIT_V(2); PG8_BAR;
        PG8_STAGE(PG8_SB(1, 0), cB + kstep, voffB); PG8_STAGE(PG8_SA(1, 0), cA + kstep, voffA); PG8_STAGE(PG8_SB(1, 1), cB + hstep + kstep, voffB);
        PG8_WAIT_V(6); PG8_BAR;
    } else {
        PG8_STAGE(PG8_SB(0, 0), cB, voffB); PG8_STAGE(PG8_SA(0, 0), cA, voffA); PG8_STAGE(PG8_SB(0, 1), cB + hstep, voffB); PG8_STAGE(PG8_SA(0, 1), cA + hstep, voffA);
        if (wr == 1) PG8_BAR;
        PG8_WAIT_V(4); PG8_BAR;
        PG8_STAGE(PG8_SB(1, 0), cB + kstep, voffB); PG8_STAGE(PG8_SA(1, 0), cA + kstep, voffA); PG8_STAGE(PG8_SB(1, 1), cB + hstep + kstep, voffB);
        PG8_WAIT_V(6); PG8_BAR;
    }
    for (;;) {
        const bool has_next = S.next(ui + 1, nxt);
        const char* nA = has_next ? (const char*)g.A + (size_t)nxt.pm * tstep : cA; const char* nB = has_next ? (const char*)g.Bt + (size_t)nxt.pn * tstep : cB;
        for (int t = 0; t < nt; t += 2) {
            const bool last = (t == nt - 2);
            const char* a1 = cA + (size_t)(t + 1) * kstep;
            const char* a2 = last ? nA : cA + (size_t)(t + 2) * kstep; const char* b2 = last ? nB : cB + (size_t)(t + 2) * kstep;
            const char* a3 = a2 + kstep; const char* b3 = b2 + kstep;
            if (last && has_next) S.a_ready(nxt);
            if constexpr (SP2) {
            PG8_LDB(B0, 0, 0); PG8_LDB(B1, 0, 1); PG8_SCHED; PG8_LDA(At, 0, 0); PG8_STAGE(PG8_SA(1, 1), a1 + hstep, voffA);
            PG8_WAIT_V(8); PG8_WAIT_L(0); PG8_BAR; PG8_MMA(0, 0, At, B0); PG8_MMA(0, 1, At, B1); PG8_BAR; PG8_SCHED;
            PG8_LDA(At, 0, 1); PG8_STAGE(PG8_SB(0, 0), b2, voffB); PG8_STAGE(PG8_SB(0, 1), b2 + hstep, voffB); PG8_STAGE(PG8_SA(0, 0), a2, voffA);
            PG8_WAIT_V(8); PG8_WAIT_L(0); PG8_BAR; PG8_MMA(1, 0, At, B0); PG8_MMA(1, 1, At, B1); PG8_BAR; PG8_SCHED;
            PG8_LDB(B0, 1, 0); PG8_LDB(B1, 1, 1); PG8_SCHED; PG8_LDA(At, 1, 0); PG8_STAGE(PG8_SA(0, 1), a2 + hstep, voffA);
            PG8_WAIT_V(8); PG8_WAIT_L(0); PG8_BAR; PG8_MMA(0, 0, At, B0); PG8_MMA(0, 1, At, B1); PG8_BAR; PG8_SCHED;
            PG8_LDA(At, 1, 1); PG8_STAGE(PG8_SB(1, 0), b3, voffB); PG8_STAGE(PG8_SB(1, 1), b3 + hstep, voffB); PG8_STAGE(PG8_SA(1, 0), a3, voffA);
            PG8_WAIT_V(8); PG8_WAIT_L(0); PG8_BAR; PG8_MMA(1, 0, At, B0); PG8_MMA(1, 1, At, B1); PG8_BAR; PG8_SCHED;
            } else {
            PG8_LDB(B0, 0, 0); PG8_SCHED; PG8_LDA(At, 0, 0); PG8_STAGE(PG8_SA(1, 1), a1 + hstep, voffA);
            PG8_WAIT_L(8); PG8_BAR; PG8_WAIT_L(0); PG8_MMA(0, 0, At, B0); PG8_BAR; PG8_SCHED;
            PG8_LDB(B1, 0, 1); PG8_STAGE(PG8_SB(0, 0), b2, voffB);
            PG8_BAR; PG8_WAIT_L(0); PG8_MMA(0, 1, At, B1); PG8_BAR;
            PG8_LDA(At, 0, 1); PG8_STAGE(PG8_SA(0, 0), a2, voffA);
            PG8_BAR; PG8_WAIT_L(0); PG8_MMA(1, 0, At, B0); PG8_BAR; PG8_SCHED;
            PG8_STAGE(PG8_SB(0, 1), b2 + hstep, voffB);
            PG8_WAIT_V(6); PG8_BAR; PG8_MMA(1, 1, At, B1); PG8_BAR;
            PG8_LDB(B0, 1, 0); PG8_SCHED; PG8_LDA(At, 1, 0); PG8_STAGE(PG8_SA(0, 1), a2 + hstep, voffA);
            PG8_WAIT_L(8); PG8_BAR; PG8_WAIT_L(0); PG8_MMA(0, 0, At, B0); PG8_BAR; PG8_SCHED;
            PG8_LDB(B1, 1, 1); PG8_STAGE(PG8_SB(1, 0), b3, voffB);
            PG8_BAR; PG8_WAIT_L(0); PG8_MMA(0, 1, At, B1); PG8_BAR;
            PG8_LDA(At, 1, 1); PG8_STAGE(PG8_SA(1, 0), a3, voffA);
            PG8_BAR; PG8_WAIT_L(0); PG8_MMA(1, 0, At, B0); PG8_BAR; PG8_SCHED;
            PG8_STAGE(PG8_SB(1, 1), b3 + hstep, voffB);
            PG8_WAIT_V(6); PG8_BAR; PG8_MMA(1, 1, At, B1); PG8_BAR;
            }
        }
        if constexpr (ALIGN_EPI) { if (wr == 0) PG8_BAR; }
        if constexpr (!Epi::AFTER_DRAIN) { E(acc, cur, wr, wc, fr, fq); S.done(cur); }
        if (!has_next) break;
#pragma unroll
        for (int a = 0; a < 2; ++a)
#pragma unroll
            for (int b = 0; b < 2; ++b)
#pragma unroll
                for (int m = 0; m < 4; ++m)
#pragma unroll
                    for (int n = 0; n < 2; ++n) acc[a][b][m][n] = (f32x4){0.f, 0.f, 0.f, 0.f};
        cur = nxt; cA = nA; cB = nB; ++ui;
        if constexpr (ALIGN_EPI) { if (wr == 1) PG8_BAR; }
    }
    PG8_WAIT_V(0);
    if constexpr (!ALIGN_EPI) { if (wr == 0) PG8_BAR; }
    PG8_BAR;
    if constexpr (Epi::AFTER_DRAIN) { E.fused(acc, cur, wr, wc, fr, fq, lds, wid, lane); S.done(cur); }
#undef PG8_SA
#undef PG8_SB
#undef PG8_STAGE
#undef PG8_LDA
#undef PG8_LDB
#undef PG8_MMA
#undef PG8_WAIT_V
#undef PG8_WAIT_L
#undef PG8_BAR
#undef PG8_SCHED
}
}
#define GAS __attribute__((address_space(1)))
#define LAS __attribute__((address_space(3)))
typedef unsigned short bf16;
typedef unsigned v4u __attribute__((ext_vector_type(4)));
typedef float f32x4 __attribute__((ext_vector_type(4)));
typedef short bf16x8 __attribute__((ext_vector_type(8)));
typedef GAS unsigned gu32;
typedef GAS unsigned long long gu64;
#define RLX_AGENT __ATOMIC_RELAXED, __HIP_MEMORY_SCOPE_AGENT
#define LDS_WAIT() asm volatile("s_waitcnt lgkmcnt(0)" ::: "memory")
#define VM_WAIT() asm volatile("s_waitcnt vmcnt(0)" ::: "memory")
__device__ __forceinline__ unsigned long long rt() { return __builtin_amdgcn_s_memrealtime(); }
__device__ __forceinline__ unsigned f2bf(float f) { unsigned u = __builtin_bit_cast(unsigned, f); return (u + 0x7fffu + ((u >> 16) & 1u)) >> 16; }
__device__ __forceinline__ unsigned pk2(float lo, float hi) { return f2bf(lo) | (f2bf(hi) << 16); }

#define XB_TMO      128
#define XB_XCNT(j)  (256  + 64 * (j))
#define XB_XSUB(j)  (1280 + 64 * (j))
#define XB_XGEN(j)  (2304 + 64 * (j))
#define XB_TOP      3328
#define XB_TOPGEN   3392
#define XCD_BAR_WORDS 3456
#define XB_SPIN_CAP (1u << 18)

__device__ __forceinline__ unsigned xb_ld(unsigned* p)              { return __hip_atomic_load(p, __ATOMIC_RELAXED, __HIP_MEMORY_SCOPE_AGENT); }
__device__ __forceinline__ unsigned xb_add(unsigned* p, unsigned v) { return __hip_atomic_fetch_add(p, v, __ATOMIC_RELAXED, __HIP_MEMORY_SCOPE_AGENT); }
__device__ __forceinline__ unsigned xb_xcc_id() { return (unsigned)__builtin_amdgcn_s_getreg((3 << 11) | 20) & 0xFu; }
#define XB_SPIN(cond, bar) do { unsigned _sp = 0; while (cond) { __builtin_amdgcn_s_sleep(1); \
    if ((++_sp & 255u) == 0u) { if (xb_ld(&(bar)[XB_TMO])) break; if (_sp > XB_SPIN_CAP) { atomicAdd(&(bar)[XB_TMO], 1u); break; } } } } while (0)

struct XcdBarrier {
    unsigned* bar; unsigned x;
    volatile LAS unsigned* st;
};

__device__ __forceinline__ XcdBarrier xcd_barrier_post(unsigned* bar, volatile LAS unsigned* st) {
    XcdBarrier b; b.bar = bar; b.x = xb_xcc_id(); b.st = st;
    if (threadIdx.x == 0) (void)xb_add(&bar[XB_XCNT(b.x)], 1u);
    return b;
}
__device__ __forceinline__ void xcd_barrier_complete(unsigned* bar, unsigned x, unsigned& nloc, unsigned& nx) {
    const unsigned G = gridDim.x * gridDim.y * gridDim.z;
    unsigned sum, cnt, mine, sp = 0u;
    for (;;) {
        sum = 0u; cnt = 0u; mine = 0u;
#pragma unroll
        for (unsigned j = 0; j < 16; ++j) { const unsigned c = xb_ld(&bar[XB_XCNT(j)]); sum += c; cnt += (c > 0u) ? 1u : 0u; mine = (j == x) ? c : mine; }
        if (sum == G) break;
        __builtin_amdgcn_s_sleep(1);
        if ((++sp & 255u) == 0u) { if (xb_ld(&bar[XB_TMO])) break; if (sp > XB_SPIN_CAP) { atomicAdd(&bar[XB_TMO], 1u); break; } }
    }
    nloc = mine > 0u ? mine : 1u; nx = cnt > 0u ? cnt : 1u;
}

__device__ __forceinline__ void xcd_barrier(const XcdBarrier& b) {
    asm volatile("s_waitcnt vmcnt(0)" ::: "memory");
    __syncthreads();
    if (threadIdx.x == 0) {
        unsigned* bar = b.bar;
        __builtin_amdgcn_s_waitcnt(0);
        unsigned nloc = b.st[0], nx = b.st[1];
        if (nloc == 0u) { xcd_barrier_complete(bar, b.x, nloc, nx); b.st[0] = nloc; b.st[1] = nx; }
        const unsigned old = xb_add(&bar[XB_XSUB(b.x)], 1u);
        const unsigned gen = old / nloc;
        if (old + 1u == (gen + 1u) * nloc) {
            __builtin_amdgcn_fence(__ATOMIC_RELEASE, "agent");
            asm volatile("s_waitcnt vmcnt(0)" ::: "memory");
            const unsigned og = xb_add(&bar[XB_TOP], 1u);
            const unsigned tg = og / nx;
            if (og + 1u == (tg + 1u) * nx) xb_add(&bar[XB_TOPGEN], 1u);
            else XB_SPIN(xb_ld(&bar[XB_TOPGEN]) == tg, bar);
            __builtin_amdgcn_fence(__ATOMIC_ACQUIRE, "agent");
            xb_add(&bar[XB_XGEN(b.x)], 1u);
            asm volatile("s_waitcnt vmcnt(0)" ::: "memory");
        } else {
            XB_SPIN(xb_ld(&bar[XB_XGEN(b.x)]) == gen, bar);
            __builtin_amdgcn_fence(__ATOMIC_ACQUIRE, "agent");
            asm volatile("s_waitcnt vmcnt(0)" ::: "memory");
        }
    }
    __syncthreads();
}

constexpr int NWAVES = 8;
constexpr int S = 8192, DM = 4096, NP = 10752, INC = 10696, QLR = 896, KVLR = 512, NQA = 1536, NKVU = 2048, DFF = 16384, NH = 8, HD = 128, GW = 1024;
constexpr int PC_CQ = 0, PC_CKV = 896, PC_KR = 1408, PC_B = 1472, PC_C = 4544, PC_D = 7616, PC_F = 10688;
constexpr float EPS = 1e-6f;
constexpr float LOG2E = 1.4426950408889634f, LN2 = 0.6931471805599453f;
constexpr size_t MiB = 1u << 20;
constexpr size_t WS_CTL = 0, CTL_ZERO_BYTES = 1 * MiB;
constexpr size_t WS_COS64 = 1 * MiB, WS_SIN64 = 2 * MiB, WS_COS32 = 3 * MiB, WS_SIN32 = 3 * MiB + 512 * 1024;
constexpr size_t WS_PF = 4 * MiB, WS_LOGF = 4 * MiB + 256 * 1024, WS_CK = 4 * MiB + 512 * 1024, WS_LSE = 5 * MiB;
constexpr size_t WS_W0 = 8 * MiB, WS_WSTRIDE = 378 * MiB;
constexpr size_t WO_IN = 0, WO_UQ = 84 * MiB, WO_UKV = 87 * MiB, WO_O = 89 * MiB, WO_UP = 121 * MiB, WO_DN = 249 * MiB;
constexpr size_t WS_H = 764 * MiB, WS_PROJ = 828 * MiB, WS_CQ = 996 * MiB, WS_CKV = 1010 * MiB, WS_QA = 1018 * MiB, WS_KVU = 1042 * MiB, WS_KR = 1074 * MiB;
constexpr size_t WS_O = 1075 * MiB, WS_OB = 1139 * MiB, WS_X1 = 1187 * MiB, WS_U = 1315 * MiB, WS_END = 1571 * MiB;
static_assert((size_t)NP * DM * 2 <= 84 * MiB && (size_t)S * NP * 2 <= 168 * MiB && (size_t)S * DFF * 2 <= 256 * MiB, "map");
constexpr int CW_TMO = 0, CW_CODE = 1, CW_BAR = 4096, CW_QUEUE = 16384;
constexpr int RING_OFF = 0, RING_BYTES = 131072;
constexpr int LDSCTL_OFF = RING_BYTES, MISC_OFF = LDSCTL_OFF + 320;
constexpr int LDS_BYTES = 147456;

struct Frame {
    LAS unsigned char* lds;
    volatile LAS unsigned* MISC;
    gu32* ctl;
    int tid, lane, wave, G;
};

__device__ __forceinline__ float wave_sum(float v) {
#pragma unroll
    for (int o = 1; o < 64; o <<= 1) v += __shfl_xor(v, o);
    return v;
}
__device__ __forceinline__ int opaque(int v) { asm volatile("" : "+v"(v)); return v; }
#define LFRAME Frame Fl = F; Fl.tid = opaque(F.tid); Fl.lane = Fl.tid & 63; Fl.wave = __builtin_amdgcn_readfirstlane(Fl.tid >> 6)
__device__ __forceinline__ float bf2f(unsigned short b) { return __builtin_bit_cast(float, (unsigned)b << 16); }
__device__ __forceinline__ float bflo(unsigned w) { return __builtin_bit_cast(float, w << 16); }
__device__ __forceinline__ float bfhi(unsigned w) { return __builtin_bit_cast(float, w & 0xffff0000u); }

__device__ __forceinline__ void p0_transpose_item(const float* W, int K, int N, bf16* WT, LAS float* scr, int item, int nblk, int lane) {
    const int kb = item / nblk, nb = item % nblk, k0 = 64 * kb, n0 = 32 * nb;
    const int nn = n0 + (lane & 31); const bool ok = nn < N;
#pragma unroll 8
    for (int i = 0; i < 32; ++i) { const int kk = 2 * i + (lane >> 5); scr[kk * 33 + (lane & 31)] = ok ? W[(size_t)(k0 + kk) * N + nn] : 0.f; }
    LDS_WAIT(); asm volatile("" ::: "memory");
    const int c = lane & 7;
#pragma unroll
    for (int j = 0; j < 4; ++j) { const int n = (lane >> 3) + 8 * j; const LAS float* s = scr + (8 * c) * 33 + n;
        v4u o; o.x = pk2(s[0 * 33], s[1 * 33]); o.y = pk2(s[2 * 33], s[3 * 33]); o.z = pk2(s[4 * 33], s[5 * 33]); o.w = pk2(s[6 * 33], s[7 * 33]);
        *(GAS v4u*)(WT + (size_t)(n0 + n) * K + k0 + 8 * c) = o; }
    LDS_WAIT(); asm volatile("" ::: "memory");
}
__device__ __forceinline__ void sincos_d(double a, float& sn, float& cs) {
    const double k = __builtin_rint(a * 0.15915494309189535);
    double r = __builtin_fma(-k, 6.283185307179586, a); r = __builtin_fma(-k, 2.4492935982947064e-16, r);
    const double q = __builtin_rint(r * 0.6366197723675814);
    double x = __builtin_fma(-q, 1.5707963267948966, r); x = __builtin_fma(-q, 6.123233995736766e-17, x);
    const double x2 = x * x;
    double sp = 1.0 / 6227020800.0; sp = sp * x2 - 1.0 / 39916800.0; sp = sp * x2 + 1.0 / 362880.0; sp = sp * x2 - 1.0 / 5040.0; sp = sp * x2 + 1.0 / 120.0; sp = sp * x2 - 1.0 / 6.0; sp = sp * x2 * x + x;
    double cp = -1.0 / 87178291200.0; cp = cp * x2 + 1.0 / 479001600.0; cp = cp * x2 - 1.0 / 3628800.0; cp = cp * x2 + 1.0 / 40320.0; cp = cp * x2 - 1.0 / 720.0; cp = cp * x2 + 1.0 / 24.0; cp = cp * x2 - 0.5; cp = cp * x2 + 1.0;
    const int qi = ((int)q) & 3;
    const double s = (qi == 0) ? sp : (qi == 1) ? cp : (qi == 2) ? -sp : -cp;
    const double c = (qi == 0) ? cp : (qi == 1) ? -sp : (qi == 2) ? -cp : sp;
    sn = (float)s; cs = (float)c;
}
__device__ __forceinline__ double powi_d(double c, int i) { double r = 1.0, b = c; for (int e = 0; e < 5; ++e) { if (i & (1 << e)) r *= b; b *= b; } return r; }

struct Ptrs {
    const float *x, *g_attn, *w_in, *g_q, *g_kv, *w_uq, *w_uk, *w_uv, *b_f, *g_out, *w_o, *g_mlp, *w_up, *w_down, *g_final;
    float* out; unsigned char* ws;
};
__device__ __forceinline__ bf16* wsb(const Ptrs& P, size_t off) { return (bf16*)(P.ws + off); }
__device__ __forceinline__ float* wsf(const Ptrs& P, size_t off) { return (float*)(P.ws + off); }

__device__ __forceinline__ void p0_prologue(Frame& F, const Ptrs& P) {
    LAS float* scr = (LAS float*)(F.lds + RING_OFF + F.wave * 16384);
    const int gw = blockIdx.x * NWAVES + F.wave, NGW = F.G * NWAVES;
    constexpr int I_IN = (DM / 64) * (NP / 32), I_UQ = (QLR / 64) * (NQA / 32), I_UK = (KVLR / 64) * (GW / 32), I_O = (DM / 64) * (DM / 32), I_UP = (DM / 64) * (DFF / 32), I_DN = (DFF / 64) * (DM / 32);
    constexpr int PER = I_IN + I_UQ + 2 * I_UK + I_O + I_UP + I_DN;
    for (int it = gw; it < 2 * PER; it += NGW) {
        const int l = it / PER; int r = it - l * PER; const size_t wb = WS_W0 + (size_t)l * WS_WSTRIDE;
        if (r < I_IN) { p0_transpose_item(P.w_in + (size_t)l * DM * INC, DM, INC, wsb(P, wb + WO_IN), scr, r, NP / 32, F.lane); continue; } r -= I_IN;
        if (r < I_UQ) { p0_transpose_item(P.w_uq + (size_t)l * QLR * NQA, QLR, NQA, wsb(P, wb + WO_UQ), scr, r, NQA / 32, F.lane); continue; } r -= I_UQ;
        if (r < I_UK) { p0_transpose_item(P.w_uk + (size_t)l * KVLR * GW, KVLR, GW, wsb(P, wb + WO_UKV), scr, r, GW / 32, F.lane); continue; } r -= I_UK;
        if (r < I_UK) { p0_transpose_item(P.w_uv + (size_t)l * KVLR * GW, KVLR, GW, wsb(P, wb + WO_UKV) + (size_t)GW * KVLR, scr, r, GW / 32, F.lane); continue; } r -= I_UK;
        if (r < I_O) { p0_transpose_item(P.w_o + (size_t)l * DM * DM, DM, DM, wsb(P, wb + WO_O), scr, r, DM / 32, F.lane); continue; } r -= I_O;
        if (r < I_UP) { p0_transpose_item(P.w_up + (size_t)l * DM * DFF, DM, DFF, wsb(P, wb + WO_UP), scr, r, DFF / 32, F.lane); continue; } r -= I_UP;
        p0_transpose_item(P.w_down + (size_t)l * DFF * DM, DFF, DM, wsb(P, wb + WO_DN), scr, r, DM / 32, F.lane);
    }
    const int gt = blockIdx.x * (NWAVES * 64) + F.tid, NGT = F.G * NWAVES * 64;
    for (int e = gt; e < S * 48; e += NGT) {
        const int pos = e / 48, j = e % 48;
        float sn, cs;
        if (j < 32) { const double inv = powi_d(0.6636012376960885, j); sincos_d((double)pos * inv, sn, cs); wsf(P, WS_COS64)[pos * 32 + j] = cs; wsf(P, WS_SIN64)[pos * 32 + j] = sn; }
        else { const int i = j - 32; const double inv = powi_d(0.44036660267178046, i); sincos_d((double)pos * inv, sn, cs); wsf(P, WS_COS32)[pos * 16 + i] = cs; wsf(P, WS_SIN32)[pos * 16 + i] = sn; }
    }
}

template <bool F32OUT>
__device__ __forceinline__ void rms_rows(Frame& F, const float* X, const float* g, bf16* ob, float* of) {
    const int gw = blockIdx.x * NWAVES + F.wave, NGW = F.G * NWAVES;
    for (int m = gw; m < S; m += NGW) {
        const GAS f32x4* xr = (const GAS f32x4*)(X + (size_t)m * DM) + F.lane;
        f32x4 v[16]; float s = 0.f;
#pragma unroll
        for (int j = 0; j < 16; ++j) { v[j] = xr[64 * j]; s += (v[j].x * v[j].x + v[j].y * v[j].y) + (v[j].z * v[j].z + v[j].w * v[j].w); }
        const float rstd = 1.f / sqrtf(wave_sum(s) * (1.f / DM) + EPS);
        const GAS f32x4* gr = (const GAS f32x4*)g + F.lane;
        if (F32OUT) { GAS f32x4* o = (GAS f32x4*)(of + (size_t)m * DM) + F.lane;
#pragma unroll
            for (int j = 0; j < 16; ++j) { const f32x4 gg = gr[64 * j]; o[64 * j] = v[j] * rstd * gg; } }
        else { GAS unsigned long long* o8 = (GAS unsigned long long*)(ob + (size_t)m * DM) + F.lane;
#pragma unroll
            for (int j = 0; j < 16; ++j) { const f32x4 gg = gr[64 * j]; const f32x4 y = v[j] * rstd * gg;
                o8[64 * j] = (unsigned long long)pk2(y.x, y.y) | ((unsigned long long)pk2(y.z, y.w) << 32); } }
    }
}

__device__ __forceinline__ void postproj_rows(Frame& F, const Ptrs& P, int l) {
    const int gw = blockIdx.x * NWAVES + F.wave, NGW = F.G * NWAVES, lane = F.lane;
    bf16* PROJ = wsb(P, WS_PROJ); bf16* CQ = wsb(P, WS_CQ); bf16* CKV = wsb(P, WS_CKV); bf16* KR = wsb(P, WS_KR);
    const float* gq = P.g_q + l * QLR; const float* gkv = P.g_kv + l * KVLR; const float* bfp = P.b_f + l * NH;
    const float* C64 = wsf(P, WS_COS64); const float* S64 = wsf(P, WS_SIN64); const float* C32 = wsf(P, WS_COS32); const float* S32 = wsf(P, WS_SIN32);
    for (int m = gw; m < S; m += NGW) {
        bf16* prow = PROJ + (size_t)m * NP;
        {
            const GAS unsigned* pr = (const GAS unsigned*)(prow + PC_CQ) + lane; unsigned w[7]; float s = 0.f;
#pragma unroll
            for (int j = 0; j < 7; ++j) { w[j] = pr[64 * j]; const float a = bflo(w[j]), b = bfhi(w[j]); s += a * a + b * b; }
            const float rstd = 1.f / sqrtf(wave_sum(s) * (1.f / QLR) + EPS);
            GAS unsigned* o = (GAS unsigned*)(CQ + (size_t)m * QLR) + lane;
#pragma unroll
            for (int j = 0; j < 7; ++j) { const int c = 2 * (lane + 64 * j); o[64 * j] = pk2(bflo(w[j]) * rstd * gq[c], bfhi(w[j]) * rstd * gq[c + 1]); }
        }
        {
            const v4u w = *(const GAS v4u*)(prow + PC_CKV + 8 * lane); float s = 0.f; float f[8];
            f[0] = bflo(w.x); f[1] = bfhi(w.x); f[2] = bflo(w.y); f[3] = bfhi(w.y); f[4] = bflo(w.z); f[5] = bfhi(w.z); f[6] = bflo(w.w); f[7] = bfhi(w.w);
#pragma unroll
            for (int e = 0; e < 8; ++e) s += f[e] * f[e];
            const float rstd = 1.f / sqrtf(wave_sum(s) * (1.f / KVLR) + EPS);
            const float* g8 = gkv + 8 * lane; v4u o;
            o.x = pk2(f[0] * rstd * g8[0], f[1] * rstd * g8[1]); o.y = pk2(f[2] * rstd * g8[2], f[3] * rstd * g8[3]); o.z = pk2(f[4] * rstd * g8[4], f[5] * rstd * g8[5]); o.w = pk2(f[6] * rstd * g8[6], f[7] * rstd * g8[7]);
            *(GAS v4u*)(CKV + (size_t)m * KVLR + 8 * lane) = o;
        }
        if (lane < 32) {
            const float t1 = bf2f(prow[PC_KR + lane]), t2 = bf2f(prow[PC_KR + 32 + lane]); const float c = C64[m * 32 + lane], sn = S64[m * 32 + lane];
            KR[(size_t)m * 64 + lane] = (bf16)f2bf(t1 * c - t2 * sn); KR[(size_t)m * 64 + 32 + lane] = (bf16)f2bf(t1 * sn + t2 * c);
        }
#pragma unroll
        for (int j = 0; j < 4; ++j) {
            const int id = lane + 64 * j, which = id >> 7, h = (id >> 4) & 7, d = id & 15; const int col = PC_B + which * GW + h * HD + d;
            const float t1 = bf2f(prow[col]), t2 = bf2f(prow[col + 16]); const float c = C32[m * 16 + d], sn = S32[m * 16 + d];
            prow[col] = (bf16)f2bf(t1 * c - t2 * sn); prow[col + 16] = (bf16)f2bf(t1 * sn + t2 * c);
        }
        if (lane < NH) {
            const float z = wsf(P, WS_PF)[(size_t)m * 8 + lane] + bfp[lane];
            wsf(P, WS_LOGF)[(size_t)m * 8 + lane] = fminf(z, 0.f) - log1pf(expf(-fabsf(z)));
        }
    }
}

__device__ __forceinline__ void cumsum_head(Frame& F, const Ptrs& P, int h) {
    const float* LOGF = wsf(P, WS_LOGF); float* CK = wsf(P, WS_CK) + (size_t)h * S;
    LAS float* wt = (LAS float*)(F.lds + RING_OFF);
    float v[16]; float run = 0.f;
#pragma unroll
    for (int j = 0; j < 16; ++j) { run += LOGF[(size_t)(16 * F.tid + j) * 8 + h]; v[j] = run; }
    float inc = run;
#pragma unroll
    for (int o = 1; o < 64; o <<= 1) { const float t = __shfl_up(inc, o); if (F.lane >= o) inc += t; }
    if (F.lane == 63) wt[F.wave] = inc;
    __syncthreads();
    float base = inc - run;
    for (int w = 0; w < F.wave; ++w) base += wt[w];
#pragma unroll
    for (int j = 0; j < 16; ++j) CK[16 * F.tid + j] = base + v[j];
    __syncthreads();
}


namespace fa {
typedef short bf16x8 __attribute__((ext_vector_type(8)));
typedef short s16x4 __attribute__((ext_vector_type(4)));
typedef float f32x16 __attribute__((ext_vector_type(16)));
typedef float f32x4 __attribute__((ext_vector_type(4)));
typedef unsigned u32x4 __attribute__((ext_vector_type(4)));
constexpr int L_V = 0, L_K = 32768, L_KR = 65536, L_WS = 81920, L_BIAS = 83968, L_FLAG = 84480, L_ITEM = 84608;
constexpr int SHM = 16384;
#define FA_LP(T, off) ((LAS T*)(lds + (off)))
__device__ __forceinline__ int kswz(int row, int colB) { return row * 256 + (colB ^ ((row & 7) << 4)); }
__device__ __forceinline__ int krswz(int row, int colB) { return row * 128 + (colB ^ ((row & 7) << 4)); }
__device__ __forceinline__ int v_st(int k, int c) { const int kk = (k & ~0xC) | ((k & 4) << 1) | ((k & 8) >> 1); return ((kk >> 3) * 4 + (c >> 5)) * 512 + ((kk & 7) * 32 + (c & 31)) * 2; }
__device__ __forceinline__ int v_rd_base(int lane) { return ((lane & 3) << 3) | (((lane >> 2) & 3) << 6) | (((lane >> 4) & 1) << 5) | (((lane >> 5) & 1) << 8); }
constexpr int v_rd_off(int d0, int ks, int half) { return d0 * 512 + ks * 4096 + half * 2048; }
__device__ __forceinline__ int crow(int r, int hi) { return (r & 3) + 8 * (r >> 2) + 4 * hi; }
__device__ __forceinline__ unsigned cvtpk(float lo, float hi) { unsigned r; asm volatile("v_cvt_pk_bf16_f32 %0, %1, %2" : "=v"(r) : "v"(lo), "v"(hi)); return r; }
__device__ __forceinline__ float xsum(float v) { auto rr = __builtin_amdgcn_permlane32_swap(__float_as_uint(v), __float_as_uint(v), false, false); return __uint_as_float(rr[0]) + __uint_as_float(rr[1]); }
__device__ __forceinline__ float xmax(float v) { auto rr = __builtin_amdgcn_permlane32_swap(__float_as_uint(v), __float_as_uint(v), false, false); return fmaxf(__uint_as_float(rr[0]), __uint_as_float(rr[1])); }
#define FA_SBAR() __builtin_amdgcn_sched_barrier(0)

struct UnitRef {
    const bf16* Q; int qp;
    const bf16* K; int kp;
    const bf16* V; int vp;
    const bf16* KR;
    const float* CK;
    const float* COS; const float* SIN;
    bf16* O; int op;
    float* LSE; int lp;
    int P0;
};

template <int VAR>
__device__ __forceinline__ void attn_unit(LAS unsigned char* lds, const UnitRef& U, int tid) {
    constexpr int NQ = (VAR == 0) ? 12 : 8;
    constexpr float SCALE = (VAR == 0) ? 0.07216878364870323f : 0.08838834764831845f;
    constexpr float C2 = SCALE * 1.4426950408889634f;
    constexpr float THR2 = 8.f * 1.4426950408889634f;
    const int wid = __builtin_amdgcn_readfirstlane(tid >> 6), lane = tid & 63, r32 = lane & 31, hi = lane >> 5;
    const int W = (VAR == 1) ? 129 : 0x40000000;
    const int P0 = U.P0;
    int j_lo = 0; if (VAR == 1) { const int lowk = P0 - 128; j_lo = lowk > 0 ? lowk / 64 : 0; }
    const int j_hi = (P0 + 255) / 64 + 1;
    const int NT = j_hi - j_lo;
    const int qlo = P0 + wid * 32;
    const int qm = qlo + r32 - 4 * hi - (VAR == 2 ? 1 : 0);
    bf16x8 qr[NQ];
    { const bf16* qrow = U.Q + (size_t)(wid * 32 + r32) * U.qp + hi * 8;
#pragma unroll
      for (int d0 = 0; d0 < 8; ++d0) qr[d0] = *(const GAS bf16x8*)(qrow + d0 * 16);
      if constexpr (VAR == 0) {
          bf16x8 f[4];
#pragma unroll
          for (int d = 0; d < 4; ++d) f[d] = *(const GAS bf16x8*)(qrow + 128 + d * 16);
          const int pos = qlo + r32;
#pragma unroll
          for (int d = 0; d < 2; ++d) {
              const f32x4 c0 = *(const GAS f32x4*)(U.COS + (size_t)pos * 32 + d * 16 + hi * 8), c1 = *(const GAS f32x4*)(U.COS + (size_t)pos * 32 + d * 16 + hi * 8 + 4);
              const f32x4 s0 = *(const GAS f32x4*)(U.SIN + (size_t)pos * 32 + d * 16 + hi * 8), s1 = *(const GAS f32x4*)(U.SIN + (size_t)pos * 32 + d * 16 + hi * 8 + 4);
              float n1[8], n2[8];
#pragma unroll
              for (int j = 0; j < 8; ++j) { const float t1 = bf2f((unsigned short)f[d][j]), t2 = bf2f((unsigned short)f[d + 2][j]); const float c = j < 4 ? c0[j & 3] : c1[j & 3], s = j < 4 ? s0[j & 3] : s1[j & 3];
                  n1[j] = t1 * c - t2 * s; n2[j] = t1 * s + t2 * c; }
              u32x4 w1 = {pk2(n1[0], n1[1]), pk2(n1[2], n1[3]), pk2(n1[4], n1[5]), pk2(n1[6], n1[7])}, w2 = {pk2(n2[0], n2[1]), pk2(n2[2], n2[3]), pk2(n2[4], n2[5]), pk2(n2[6], n2[7])};
              qr[8 + d] = __builtin_bit_cast(bf16x8, w1); qr[10 + d] = __builtin_bit_cast(bf16x8, w2);
          }
      }
    }
    const int sr = tid >> 4, sc = (tid & 15) * 8;
    const int kws = kswz(sr, sc * 2), vst0 = v_st(sr, sc), vst1 = v_st(32 + sr, sc);
    const int krr = tid >> 3, krc = (tid & 7) * 8, krw = krswz(krr, krc * 2);
    bf16x8 st_k0, st_k1, st_v0, st_v1, st_kr; float st_b = 0.f;
    float cref = 0.f; if constexpr (VAR == 3) cref = U.CK[P0];
#define FA_SLOAD(kb) do { const bf16* kp_ = U.K + (size_t)((kb) + sr) * U.kp + sc; const bf16* vp_ = U.V + (size_t)((kb) + sr) * U.vp + sc; \
        st_k0 = *(const GAS bf16x8*)kp_; st_k1 = *(const GAS bf16x8*)(kp_ + (size_t)32 * U.kp); st_v0 = *(const GAS bf16x8*)vp_; st_v1 = *(const GAS bf16x8*)(vp_ + (size_t)32 * U.vp); \
        if constexpr (VAR == 0) st_kr = *(const GAS bf16x8*)(U.KR + (size_t)((kb) + krr) * 64 + krc); \
        if constexpr (VAR == 3) { if (tid < 64) st_b = U.CK[(kb) + tid]; } } while (0)
#define FA_SWRITE(bf) do { *FA_LP(bf16x8, L_K + (bf) * SHM + kws) = st_k0; *FA_LP(bf16x8, L_K + (bf) * SHM + kws + 32 * 256) = st_k1; \
        *FA_LP(bf16x8, L_V + (bf) * SHM + vst0) = st_v0; *FA_LP(bf16x8, L_V + (bf) * SHM + vst1) = st_v1; \
        if constexpr (VAR == 0) *FA_LP(bf16x8, L_KR + (bf) * 8192 + krw) = st_kr; \
        if constexpr (VAR == 3) { if (tid < 64) *FA_LP(float, L_BIAS + (bf) * 256 + tid * 4) = (cref - st_b) * 1.4426950408889634f; } } while (0)
    LAS float* li_l = FA_LP(float, L_WS + wid * 256); LAS float* al_l = li_l + 32;
    const unsigned vb0 = (unsigned)(uintptr_t)(lds + L_V) + v_rd_base(lane);
    unsigned kb4[4];
#pragma unroll
    for (int dd = 0; dd < 4; ++dd) kb4[dd] = (unsigned)(uintptr_t)(lds + L_K) + kswz(r32, (dd * 16 + hi * 8) * 2);
    unsigned krb4[4];
    if constexpr (VAR == 0) {
#pragma unroll
        for (int dd = 0; dd < 4; ++dd) krb4[dd] = (unsigned)(uintptr_t)(lds + L_KR) + krswz(r32, (dd * 16 + hi * 8) * 2);
    }
    float m2 = -1e30f, l_reg = 0.f, R2 = 0.f;
    f32x16 o[4];
#pragma unroll
    for (int d = 0; d < 4; ++d)
#pragma unroll
        for (int r = 0; r < 16; ++r) o[d][r] = 0.f;
    bool wdone = false;
    FA_SLOAD((j_hi - 1) * 64);
    asm volatile("s_waitcnt vmcnt(0)" ::: "memory");
    FA_SWRITE(0);
    __syncthreads();

#define FA_TRRD(dst, off) asm volatile("ds_read_b64_tr_b16 %0, %1 offset:%2" : "=&v"(dst) : "v"(vb0), "i"(off) : "memory")
#define FA_PV_D0(BUF, d0) do { s16x4 l0, l1, l2, l3, h0, h1, h2, h3; constexpr int b_ = (BUF) * SHM + v_rd_off(d0, 0, 0); \
        FA_TRRD(l0, b_); FA_TRRD(h0, b_ + 2048); FA_TRRD(l1, b_ + 4096); FA_TRRD(h1, b_ + 6144); FA_TRRD(l2, b_ + 8192); FA_TRRD(h2, b_ + 10240); FA_TRRD(l3, b_ + 12288); FA_TRRD(h3, b_ + 14336); \
        asm volatile("s_waitcnt lgkmcnt(0)" ::: "memory"); FA_SBAR(); \
        o[d0] = __builtin_amdgcn_mfma_f32_32x32x16_bf16(pa0, (bf16x8){l0[0], l0[1], l0[2], l0[3], h0[0], h0[1], h0[2], h0[3]}, o[d0], 0, 0, 0); \
        o[d0] = __builtin_amdgcn_mfma_f32_32x32x16_bf16(pa1, (bf16x8){l1[0], l1[1], l1[2], l1[3], h1[0], h1[1], h1[2], h1[3]}, o[d0], 0, 0, 0); \
        o[d0] = __builtin_amdgcn_mfma_f32_32x32x16_bf16(pa2, (bf16x8){l2[0], l2[1], l2[2], l2[3], h2[0], h2[1], h2[2], h2[3]}, o[d0], 0, 0, 0); \
        o[d0] = __builtin_amdgcn_mfma_f32_32x32x16_bf16(pa3, (bf16x8){l3[0], l3[1], l3[2], l3[3], h3[0], h3[1], h3[2], h3[3]}, o[d0], 0, 0, 0); } while (0)
#define FA_PK4(P, B_, OUT) do { unsigned a0 = cvtpk(P[B_ + 0], P[B_ + 1]), a1 = cvtpk(P[B_ + 2], P[B_ + 3]); unsigned b0 = cvtpk(P[B_ + 4], P[B_ + 5]), b1 = cvtpk(P[B_ + 6], P[B_ + 7]); \
        auto r0 = __builtin_amdgcn_permlane32_swap(a0, b0, false, false); auto r1 = __builtin_amdgcn_permlane32_swap(a1, b1, false, false); \
        u32x4 w = {r0[0], r1[0], r0[1], r1[1]}; OUT = __builtin_bit_cast(bf16x8, w); } while (0)

#define FA_STEP(BUF, jt) do { \
        const int kb = (jt) * 64; const bool more = (jt) > j_lo; \
        if (more) FA_SLOAD(kb - 64); \
        const bool act = !wdone && (kb <= qlo + 31) && (kb + 63 >= qlo - W + 1); \
        if (act) { \
            f32x16 p0, p1; \
            _Pragma("unroll") for (int r = 0; r < 16; ++r) { p0[r] = 0.f; p1[r] = 0.f; } \
            _Pragma("unroll") for (int d0 = 0; d0 < 8; ++d0) { const unsigned a = kb4[d0 & 3] + (d0 >> 2) * 128 + (BUF) * SHM; \
                const bf16x8 b0 = *(const LAS bf16x8*)(uintptr_t)a; const bf16x8 b1 = *(const LAS bf16x8*)(uintptr_t)(a + 32 * 256); \
                p0 = __builtin_amdgcn_mfma_f32_32x32x16_bf16(b0, qr[d0], p0, 0, 0, 0); p1 = __builtin_amdgcn_mfma_f32_32x32x16_bf16(b1, qr[d0], p1, 0, 0, 0); } \
            if constexpr (VAR == 0) { \
                _Pragma("unroll") for (int d0 = 0; d0 < 4; ++d0) { const unsigned a = krb4[d0] + (BUF) * 8192; \
                    const bf16x8 b0 = *(const LAS bf16x8*)(uintptr_t)a; const bf16x8 b1 = *(const LAS bf16x8*)(uintptr_t)(a + 32 * 128); \
                    p0 = __builtin_amdgcn_mfma_f32_32x32x16_bf16(b0, qr[8 + d0], p0, 0, 0, 0); p1 = __builtin_amdgcn_mfma_f32_32x32x16_bf16(b1, qr[8 + d0], p1, 0, 0, 0); } } \
            bf16x8 pa0, pa1, pa2, pa3; \
            const int dq = qm - kb; \
            const bool needmask = (kb + 63 >= qlo) || (kb <= qlo + 31 - W); \
            if constexpr (VAR == 2) { \
                  \
                _Pragma("unroll") for (int r = 0; r < 16; ++r) { p0[r] = fminf(p0[r] * C2, 100.f); p1[r] = fminf(p1[r] * C2, 100.f); } \
                f32x16 x0, x1; \
                _Pragma("unroll") for (int r = 0; r < 16; ++r) { x0[r] = __builtin_amdgcn_logf(1.f + __builtin_amdgcn_exp2f(p0[r])); x1[r] = __builtin_amdgcn_logf(1.f + __builtin_amdgcn_exp2f(p1[r])); } \
                if (needmask) { _Pragma("unroll") for (int r = 0; r < 16; ++r) { const int c = (r & 3) + 8 * (r >> 2); \
                    if (dq - c < 0) { x0[r] = 0.f; p0[r] = -__builtin_inff(); } if (dq - c - 32 < 0) { x1[r] = 0.f; p1[r] = -__builtin_inff(); } } } \
                float S0[4], S1[4], C0[4], C1[4]; \
                _Pragma("unroll") for (int i = 0; i < 4; ++i) { S0[i] = (x0[4 * i] + x0[4 * i + 1]) + (x0[4 * i + 2] + x0[4 * i + 3]); S1[i] = (x1[4 * i] + x1[4 * i + 1]) + (x1[4 * i + 2] + x1[4 * i + 3]); \
                    C0[i] = xsum(S0[i]); C1[i] = xsum(S1[i]); } \
                const float fsel = hi ? 0.f : 1.f; \
                float E1[4], E0[4]; E1[3] = 0.f; E1[2] = C1[3]; E1[1] = E1[2] + C1[2]; E1[0] = E1[1] + C1[1]; const float T1 = E1[0] + C1[0]; \
                E0[3] = 0.f; E0[2] = C0[3]; E0[1] = E0[2] + C0[2]; E0[0] = E0[1] + C0[1]; const float T0 = E0[0] + C0[0]; \
                _Pragma("unroll") for (int i = 0; i < 4; ++i) { \
                    float ag = R2 + E1[i] + fsel * (C1[i] - S1[i]); \
                    float a3 = ag, a2 = a3 + x1[4 * i + 3], a1 = a2 + x1[4 * i + 2], a0 = a1 + x1[4 * i + 1]; \
                    p1[4 * i + 3] = __builtin_amdgcn_exp2f(p1[4 * i + 3] - x1[4 * i + 3] - a3); p1[4 * i + 2] = __builtin_amdgcn_exp2f(p1[4 * i + 2] - x1[4 * i + 2] - a2); \
                    p1[4 * i + 1] = __builtin_amdgcn_exp2f(p1[4 * i + 1] - x1[4 * i + 1] - a1); p1[4 * i + 0] = __builtin_amdgcn_exp2f(p1[4 * i + 0] - x1[4 * i + 0] - a0); \
                    ag = R2 + T1 + E0[i] + fsel * (C0[i] - S0[i]); \
                    a3 = ag; a2 = a3 + x0[4 * i + 3]; a1 = a2 + x0[4 * i + 2]; a0 = a1 + x0[4 * i + 1]; \
                    p0[4 * i + 3] = __builtin_amdgcn_exp2f(p0[4 * i + 3] - x0[4 * i + 3] - a3); p0[4 * i + 2] = __builtin_amdgcn_exp2f(p0[4 * i + 2] - x0[4 * i + 2] - a2); \
                    p0[4 * i + 1] = __builtin_amdgcn_exp2f(p0[4 * i + 1] - x0[4 * i + 1] - a1); p0[4 * i + 0] = __builtin_amdgcn_exp2f(p0[4 * i + 0] - x0[4 * i + 0] - a0); } \
                R2 += T0 + T1; \
                FA_PK4(p0, 0, pa0); FA_PK4(p0, 8, pa1); FA_PK4(p1, 0, pa2); FA_PK4(p1, 8, pa3); \
            } else { \
                if constexpr (VAR == 3) { \
                    _Pragma("unroll") for (int g = 0; g < 4; ++g) { const f32x4 b0 = *FA_LP(f32x4, L_BIAS + (BUF) * 256 + (8 * g + 4 * hi) * 4), b1 = *FA_LP(f32x4, L_BIAS + (BUF) * 256 + (32 + 8 * g + 4 * hi) * 4); \
                        _Pragma("unroll") for (int e = 0; e < 4; ++e) { p0[4 * g + e] = fmaf(p0[4 * g + e], C2, b0[e]); p1[4 * g + e] = fmaf(p1[4 * g + e], C2, b1[e]); } } \
                } else { _Pragma("unroll") for (int r = 0; r < 16; ++r) { p0[r] *= C2; p1[r] *= C2; } } \
                if (needmask) { _Pragma("unroll") for (int r = 0; r < 16; ++r) { const int c = (r & 3) + 8 * (r >> 2); \
                    if ((unsigned)(dq - c) >= (unsigned)W) p0[r] = -__builtin_inff(); if ((unsigned)(dq - c - 32) >= (unsigned)W) p1[r] = -__builtin_inff(); } } \
                float pmax = p0[0]; \
                _Pragma("unroll") for (int r = 1; r < 16; ++r) pmax = fmaxf(pmax, p0[r]); \
                _Pragma("unroll") for (int r = 0; r < 16; ++r) pmax = fmaxf(pmax, p1[r]); \
                pmax = xmax(pmax); \
                float alpha = 1.f; \
                if (!__all(pmax - m2 <= THR2)) { const float mn = fmaxf(m2, pmax); alpha = __builtin_amdgcn_exp2f(m2 - mn); m2 = mn; } \
                float ps = 0.f; \
                _Pragma("unroll") for (int r = 0; r < 16; ++r) { p0[r] = __builtin_amdgcn_exp2f(p0[r] - m2); p1[r] = __builtin_amdgcn_exp2f(p1[r] - m2); ps += p0[r] + p1[r]; } \
                ps = xsum(ps); l_reg = l_reg * alpha + ps; \
                if (__any(alpha < 1.f)) { if (hi == 0) al_l[r32] = alpha; asm volatile("s_waitcnt lgkmcnt(0)" ::: "memory"); \
                    _Pragma("unroll") for (int r = 0; r < 16; ++r) { const float a_ = al_l[crow(r, hi)]; o[0][r] *= a_; o[1][r] *= a_; o[2][r] *= a_; o[3][r] *= a_; } } \
                FA_PK4(p0, 0, pa0); FA_PK4(p0, 8, pa1); FA_PK4(p1, 0, pa2); FA_PK4(p1, 8, pa3); \
            } \
            FA_SBAR(); FA_PV_D0(BUF, 0); FA_PV_D0(BUF, 1); FA_PV_D0(BUF, 2); FA_PV_D0(BUF, 3); \
        } \
        if (more) { asm volatile("s_waitcnt vmcnt(0)" ::: "memory"); FA_SWRITE((BUF) ^ 1); } \
        if constexpr (VAR == 2) { wdone = wdone || __all(R2 > 64.f); if (lane == 0) *FA_LP(int, L_FLAG + (BUF) * 32 + wid * 4) = wdone ? 1 : 0; } \
        __syncthreads(); \
        if constexpr (VAR == 2) { int nd = 0; _Pragma("unroll") for (int w_ = 0; w_ < 8; ++w_) nd += *FA_LP(int, L_FLAG + (BUF) * 32 + w_ * 4); if (nd == 8) goto fa_done; } \
    } while (0)

    for (int jt = j_hi - 1; jt >= j_lo; jt -= 2) {
        FA_STEP(0, jt);
        if (jt - 1 < j_lo) break;
        FA_STEP(1, jt - 1);
    }
fa_done:
    {
        const int tid2 = opaque(tid); const int r32 = tid2 & 31, hi = (tid2 >> 5) & 1;
        float rli[16];
        if constexpr (VAR != 2) {
            if (hi == 0) li_l[r32] = l_reg; asm volatile("s_waitcnt lgkmcnt(0)" ::: "memory");
#pragma unroll
            for (int r = 0; r < 16; ++r) rli[r] = __builtin_amdgcn_rcpf(li_l[crow(r, hi)]);
        } else {
#pragma unroll
            for (int r = 0; r < 16; ++r) rli[r] = 1.f;
        }
        bf16* Ow = U.O + (size_t)(wid * 32) * U.op;
#pragma unroll
        for (int r = 0; r < 16; ++r) { const int orow = crow(r, hi);
#pragma unroll
            for (int d0 = 0; d0 < 4; ++d0) { const float v = o[d0][r] * rli[r]; const float vn = __shfl_xor(v, 1);
                if ((r32 & 1) == 0) *(GAS unsigned*)(Ow + (size_t)orow * U.op + d0 * 32 + r32) = cvtpk(v, vn); } }
        if constexpr (VAR == 1) { if (hi == 0) U.LSE[(size_t)(wid * 32 + r32) * U.lp] = (m2 + __builtin_amdgcn_logf(l_reg)) * 0.6931471805599453f; }
    }
    __syncthreads();
#undef FA_SLOAD
#undef FA_SWRITE
#undef FA_TRRD
#undef FA_PV_D0
#undef FA_PK4
#undef FA_STEP
}
}

#ifndef FASTMASK
#define FASTMASK 15
#endif
__device__ __forceinline__ void fast_attn_phase(Frame& F, const Ptrs& P, int l) {
    LAS unsigned char* lds = F.lds + RING_OFF;
    LAS int* itemw = (LAS int*)(lds + fa::L_ITEM);
    gu32* qhead = F.ctl + CW_QUEUE + 64 * l;
    bf16* PROJ = wsb(P, WS_PROJ); bf16* O = wsb(P, WS_O);
    for (;;) {
        if (F.tid == 0) *itemw = (int)__hip_atomic_fetch_add(qhead, 1u, __ATOMIC_RELAXED, __HIP_MEMORY_SCOPE_AGENT);
        __syncthreads();
        const int item = __builtin_amdgcn_readfirstlane(*itemw);
        __syncthreads();
        if (item >= 1536) break;
        fa::UnitRef U; U.KR = nullptr; U.CK = nullptr; U.COS = nullptr; U.SIN = nullptr; U.LSE = nullptr; U.lp = 0;
        if (item < 512) {
            const int qb = 31 - (item >> 4), sub = item & 15, h = sub & 7;
            if (sub < 8) {
                if (!(FASTMASK & 1)) continue;
                U.Q = wsb(P, WS_QA) + (size_t)(qb * 256) * NQA + h * 192; U.qp = NQA; U.K = wsb(P, WS_KVU) + h * HD; U.kp = NKVU; U.V = wsb(P, WS_KVU) + GW + h * HD; U.vp = NKVU;
                U.KR = wsb(P, WS_KR); U.COS = wsf(P, WS_COS64); U.SIN = wsf(P, WS_SIN64); U.O = O + (size_t)(qb * 256) * DM + h * HD; U.op = DM; U.P0 = qb * 256;
                fa::attn_unit<0>(lds, U, opaque(F.tid));
            } else {
                if (!(FASTMASK & 8)) continue;
                U.Q = PROJ + (size_t)(qb * 256) * NP + PC_D + h * HD; U.qp = NP; U.K = PROJ + PC_D + GW + h * HD; U.kp = NP; U.V = PROJ + PC_D + 2 * GW + h * HD; U.vp = NP;
                U.CK = wsf(P, WS_CK) + (size_t)h * S; U.O = O + (size_t)(qb * 256) * DM + 3 * GW + h * HD; U.op = DM; U.P0 = qb * 256;
                fa::attn_unit<3>(lds, U, opaque(F.tid));
            }
        } else if (item < 768) {
            if (!(FASTMASK & 4)) continue;
            const int i = item - 512, qb = i >> 3, h = i & 7;
            U.Q = PROJ + (size_t)(qb * 256) * NP + PC_C + h * HD; U.qp = NP; U.K = PROJ + PC_C + GW + h * HD; U.kp = NP; U.V = PROJ + PC_C + 2 * GW + h * HD; U.vp = NP;
            U.O = O + (size_t)(qb * 256) * DM + 2 * GW + h * HD; U.op = DM; U.P0 = qb * 256;
            fa::attn_unit<2>(lds, U, opaque(F.tid));
        } else {
            if (!(FASTMASK & 2)) continue;
            const int i = item - 768, br = i >> 8, rest = i & 255, h = rest & 7, blk = rest >> 3;
            const int dil = (br == 0) ? 1 : (br == 1) ? 4 : 16; const int nbr = (S / dil) / 256; const int res = blk / nbr, bi = blk - res * nbr;
            const size_t tok0 = (size_t)res + (size_t)dil * (bi * 256);
            U.Q = PROJ + tok0 * NP + PC_B + h * HD; U.qp = dil * NP; U.K = PROJ + (size_t)res * NP + PC_B + GW + h * HD; U.kp = dil * NP; U.V = PROJ + (size_t)res * NP + PC_B + 2 * GW + h * HD; U.vp = dil * NP;
            U.O = wsb(P, WS_OB) + (size_t)br * S * GW + tok0 * GW + h * HD; U.op = dil * GW; U.LSE = wsf(P, WS_LSE) + (size_t)br * S * NH + tok0 * NH + h; U.lp = dil * NH; U.P0 = bi * 256;
            fa::attn_unit<1>(lds, U, opaque(F.tid));
        }
    }
}

__device__ __forceinline__ void slow_attn_task(const Ptrs& P, int var, int h, int t, int lane) {
    const bf16* PROJ = wsb(P, WS_PROJ); bf16* O = wsb(P, WS_O);
    const bf16 *qp, *kbase, *vbase; int kp;
    float scale = 0.08838834764831845f;
    float qr_ = 0.f;
    const bf16* krb = wsb(P, WS_KR);
    if (var == 0) { qp = wsb(P, WS_QA) + (size_t)t * NQA + h * 192; kbase = wsb(P, WS_KVU) + h * HD; vbase = wsb(P, WS_KVU) + GW + h * HD; kp = NKVU; scale = 0.07216878364870323f;
        const float mine = bf2f(qp[128 + lane]); const float other = __shfl_xor(mine, 32);
        const float c = wsf(P, WS_COS64)[t * 32 + (lane & 31)], sn = wsf(P, WS_SIN64)[t * 32 + (lane & 31)];
        qr_ = (lane < 32) ? (mine * c - other * sn) : (other * sn + mine * c);
        qr_ = bf2f((bf16)f2bf(qr_)); }
    else { const int pc = (var == 1) ? PC_B : (var == 2) ? PC_C : PC_D; qp = PROJ + (size_t)t * NP + pc + h * HD; kbase = PROJ + pc + GW + h * HD; vbase = PROJ + pc + 2 * GW + h * HD; kp = NP; }
    const unsigned qw = *(const GAS unsigned*)(qp + 2 * lane); const float q0 = bflo(qw), q1 = bfhi(qw);
    float o0 = 0.f, o1 = 0.f;
    if (var == 2) {
        float R = 0.f;
        for (int s0 = t - 1; s0 >= 0; s0 -= 4) {
            float part[4]; unsigned vw[4];
#pragma unroll
            for (int i = 0; i < 4; ++i) { const int s = s0 - i; const int sc = s < 0 ? 0 : s; const unsigned kw = *(const GAS unsigned*)(kbase + (size_t)sc * kp + 2 * lane); vw[i] = *(const GAS unsigned*)(vbase + (size_t)sc * kp + 2 * lane);
                part[i] = q0 * bflo(kw) + q1 * bfhi(kw); }
#pragma unroll
            for (int i = 0; i < 4; ++i) part[i] = wave_sum(part[i]);
#pragma unroll
            for (int i = 0; i < 4; ++i) { if (s0 - i >= 0) { const float z = part[i] * scale; const float sp = fmaxf(z, 0.f) + log1pf(expf(-fabsf(z))); const float a = expf(z - sp - R); R += sp; o0 += a * bflo(vw[i]); o1 += a * bfhi(vw[i]); } }
            if (R > 100.f) break;
        }
    } else {
        float m = -1e30f, lsum = 0.f;
        const float* CK = wsf(P, WS_CK) + (size_t)h * S; const float cq = (var == 3) ? CK[t] : 0.f;
        const int nbr = (var == 1) ? 3 : 1;
        for (int br = 0; br < nbr; ++br) {
            const int dil = (var == 1) ? (br == 0 ? 1 : br == 1 ? 4 : 16) : 1; const int nk = (var == 1) ? 129 : t + 1;
            for (int j0 = 0; j0 < nk; j0 += 4) {
                float part[4]; unsigned vw[4]; float bias[4]; bool ok[4];
#pragma unroll
                for (int i = 0; i < 4; ++i) { const int j = j0 + i; const int s = t - dil * j; ok[i] = (j < nk) && (s >= 0); const int sc = ok[i] ? s : 0;
                    const unsigned kw = *(const GAS unsigned*)(kbase + (size_t)sc * kp + 2 * lane); vw[i] = *(const GAS unsigned*)(vbase + (size_t)sc * kp + 2 * lane);
                    part[i] = q0 * bflo(kw) + q1 * bfhi(kw);
                    if (var == 0) part[i] += qr_ * bf2f(krb[(size_t)sc * 64 + lane]);
                    bias[i] = (var == 3) ? (cq - CK[sc]) : 0.f; }
#pragma unroll
                for (int i = 0; i < 4; ++i) part[i] = wave_sum(part[i]);
                float sc4[4]; float mx = m;
#pragma unroll
                for (int i = 0; i < 4; ++i) { sc4[i] = ok[i] ? part[i] * scale + bias[i] : -__builtin_inff(); mx = fmaxf(mx, sc4[i]); }
                const float alpha = expf(m - mx); lsum *= alpha; o0 *= alpha; o1 *= alpha; m = mx;
#pragma unroll
                for (int i = 0; i < 4; ++i) { const float p = expf(sc4[i] - mx); lsum += p; o0 += p * bflo(vw[i]); o1 += p * bfhi(vw[i]); }
            }
        }
        o0 /= lsum; o1 /= lsum;
    }
    *(GAS unsigned*)(O + (size_t)t * DM + var * GW + h * HD + 2 * lane) = pk2(o0, o1);
}
__device__ __forceinline__ void slow_attn_phase(Frame& F, const Ptrs& P) {
    const int gw = blockIdx.x * NWAVES + F.wave, NGW = F.G * NWAVES;
    for (int k = 0; (size_t)k * NGW + gw < (size_t)S * 32; ++k) {
        const int n = k * NGW + gw; const int t = n >> 5; const int hv = (gw + k) & 31;
        if ((FASTMASK >> (hv & 3)) & 1) continue;
        slow_attn_task(P, hv & 3, hv >> 2, t, F.lane);
    }
}

__device__ __forceinline__ void groupnorm_rows(Frame& F, const Ptrs& P, int l) {
    const int gw = blockIdx.x * NWAVES + F.wave, NGW = F.G * NWAVES, lane = F.lane;
    const bf16* O = wsb(P, WS_O); bf16* ON = wsb(P, WS_H); const float* go = P.g_out + (size_t)l * DM;
    for (int m = gw; m < S; m += NGW) {
#pragma unroll
        for (int g = 0; g < 4; ++g) {
            float f[16]; float s = 0.f;
#pragma unroll
            for (int c = 0; c < 2; ++c) {
                if ((FASTMASK & 2) && g == 1) {
                    const int hh = c * 4 + (lane >> 4); const float* L = wsf(P, WS_LSE) + (size_t)m * NH + hh;
                    const float l0 = L[0], l1 = L[(size_t)S * NH], l2 = L[(size_t)2 * S * NH]; const float mx = fmaxf(l0, fmaxf(l1, l2));
                    float w0 = expf(l0 - mx), w1 = expf(l1 - mx), w2 = expf(l2 - mx); const float inv = 1.f / (w0 + w1 + w2); w0 *= inv; w1 *= inv; w2 *= inv;
                    const bf16* ob = wsb(P, WS_OB) + (size_t)m * GW + c * 512 + 8 * lane;
                    const v4u a = *(const GAS v4u*)ob, b = *(const GAS v4u*)(ob + (size_t)S * GW), d = *(const GAS v4u*)(ob + (size_t)2 * S * GW);
                    f[8 * c + 0] = w0 * bflo(a.x) + w1 * bflo(b.x) + w2 * bflo(d.x); f[8 * c + 1] = w0 * bfhi(a.x) + w1 * bfhi(b.x) + w2 * bfhi(d.x);
                    f[8 * c + 2] = w0 * bflo(a.y) + w1 * bflo(b.y) + w2 * bflo(d.y); f[8 * c + 3] = w0 * bfhi(a.y) + w1 * bfhi(b.y) + w2 * bfhi(d.y);
                    f[8 * c + 4] = w0 * bflo(a.z) + w1 * bflo(b.z) + w2 * bflo(d.z); f[8 * c + 5] = w0 * bfhi(a.z) + w1 * bfhi(b.z) + w2 * bfhi(d.z);
                    f[8 * c + 6] = w0 * bflo(a.w) + w1 * bflo(b.w) + w2 * bflo(d.w); f[8 * c + 7] = w0 * bfhi(a.w) + w1 * bfhi(b.w) + w2 * bfhi(d.w);
                    continue; }
                const v4u w = *(const GAS v4u*)(O + (size_t)m * DM + g * GW + c * 512 + 8 * lane);
                f[8 * c + 0] = bflo(w.x); f[8 * c + 1] = bfhi(w.x); f[8 * c + 2] = bflo(w.y); f[8 * c + 3] = bfhi(w.y); f[8 * c + 4] = bflo(w.z); f[8 * c + 5] = bfhi(w.z); f[8 * c + 6] = bflo(w.w); f[8 * c + 7] = bfhi(w.w); }
#pragma unroll
            for (int e = 0; e < 16; ++e) s += f[e] * f[e];
            const float rstd = 1.f / sqrtf(wave_sum(s) * (1.f / GW) + EPS);
#pragma unroll
            for (int c = 0; c < 2; ++c) { const float* g8 = go + g * GW + c * 512 + 8 * lane; v4u o;
                o.x = pk2(f[8 * c + 0] * rstd * g8[0], f[8 * c + 1] * rstd * g8[1]); o.y = pk2(f[8 * c + 2] * rstd * g8[2], f[8 * c + 3] * rstd * g8[3]);
                o.z = pk2(f[8 * c + 4] * rstd * g8[4], f[8 * c + 5] * rstd * g8[5]); o.w = pk2(f[8 * c + 6] * rstd * g8[6], f[8 * c + 7] * rstd * g8[7]);
                *(GAS v4u*)(ON + (size_t)m * DM + g * GW + c * 512 + 8 * lane) = o; }
        }
    }
}

#ifndef MK_N_LAUNCHES
#define MK_N_LAUNCHES 1
#endif
constexpr int N_PHASES = 22;
struct Args { const float* in[15]; float* out; unsigned char* ws; int ph_lo, ph_hi; };
__global__ void __launch_bounds__(NWAVES * 64, 2) fwd_kernel(Args args) {
    extern __shared__ __attribute__((aligned(16))) unsigned char lds[];
    Frame F;
    F.lds = (LAS unsigned char*)lds;
    F.MISC = (volatile LAS unsigned*)(F.lds + MISC_OFF);
    F.tid = threadIdx.x; F.lane = 0; F.wave = 0;
    F.G = gridDim.x;
    F.ctl = (gu32*)(args.ws + WS_CTL);
    Ptrs P;
    P.x = args.in[0]; P.g_attn = args.in[1]; P.w_in = args.in[2]; P.g_q = args.in[3]; P.g_kv = args.in[4]; P.w_uq = args.in[5]; P.w_uk = args.in[6]; P.w_uv = args.in[7];
    P.b_f = args.in[8]; P.g_out = args.in[9]; P.w_o = args.in[10]; P.g_mlp = args.in[11]; P.w_up = args.in[12]; P.w_down = args.in[13]; P.g_final = args.in[14];
    P.out = args.out; P.ws = args.ws;
    for (int u = F.tid; u < (LDS_BYTES - LDSCTL_OFF) / 4; u += NWAVES * 64) ((LAS unsigned*)(F.lds + LDSCTL_OFF))[u] = 0u;
    __syncthreads();
    XcdBarrier bar; bar.bar = (unsigned*)(F.ctl + CW_BAR); bar.x = 0; bar.st = nullptr;
    if (MK_N_LAUNCHES == 1) bar = xcd_barrier_post((unsigned*)(F.ctl + CW_BAR), F.MISC + 8);
    const int lo = args.ph_lo, hi = args.ph_hi;
#define IN(k) (lo <= (k) && (k) < hi)
#define SEAM(k) do { if (IN(k) && IN((k) + 1)) xcd_barrier(bar); } while (0)

    if (IN(0)) { LFRAME; p0_prologue(Fl, P); } SEAM(0);
    for (int l = 0; l < 2; ++l) {
        const int pb = 1 + 10 * l; const size_t wb = WS_W0 + (size_t)l * WS_WSTRIDE;
        const float* xin = (l == 0) ? P.x : wsf(P, WS_X1);
        if (IN(pb + 0)) { LFRAME; rms_rows<false>(Fl, xin, P.g_attn + (size_t)l * DM, wsb(P, WS_H), nullptr); } SEAM(pb + 0);
        if (IN(pb + 1)) {
            pg8::Gemm g{wsb(P, WS_H), wsb(P, wb + WO_IN), S, NP, DM}; pg8::StaticOrder So; So.init(S, NP, F.G, (int)blockIdx.x);
            pg8::EpiBf16<0> E{wsb(P, WS_PROJ), NP, wsf(P, WS_PF), PC_F};
            pg8::gemm_phase<pg8::EpiBf16<0>, pg8::StaticOrder, true, true>(F.lds + RING_OFF, g, So, E);
        } SEAM(pb + 1);
        if (IN(pb + 2)) { LFRAME; postproj_rows(Fl, P, l); } SEAM(pb + 2);
        if (IN(pb + 3)) {
            if (blockIdx.x < NH) { LFRAME; cumsum_head(Fl, P, (int)blockIdx.x); }
            { pg8::Gemm g{wsb(P, WS_CQ), wsb(P, wb + WO_UQ), S, NQA, QLR}; pg8::StaticOrder So; So.init(S, NQA, F.G, (int)blockIdx.x);
              pg8::EpiBf16<0> E{wsb(P, WS_QA), NQA, nullptr, 0};
              pg8::gemm_phase<pg8::EpiBf16<0>, pg8::StaticOrder, true, true>(F.lds + RING_OFF, g, So, E); }
            { pg8::Gemm g{wsb(P, WS_CKV), wsb(P, wb + WO_UKV), S, NKVU, KVLR}; pg8::StaticOrder So; So.init(S, NKVU, F.G, (int)blockIdx.x);
              pg8::EpiBf16<0> E{wsb(P, WS_KVU), NKVU, nullptr, 0};
              pg8::gemm_phase<pg8::EpiBf16<0>, pg8::StaticOrder, true, true>(F.lds + RING_OFF, g, So, E); }
        } SEAM(pb + 3);
        if (IN(pb + 4)) { LFRAME; if (FASTMASK != 0) fast_attn_phase(Fl, P, l); if (FASTMASK != 15) slow_attn_phase(Fl, P); } SEAM(pb + 4);
        if (IN(pb + 5)) { LFRAME; groupnorm_rows(Fl, P, l); } SEAM(pb + 5);
        if (IN(pb + 6)) {
            pg8::Gemm g{wsb(P, WS_H), wsb(P, wb + WO_O), S, DM, DM}; pg8::StaticOrder So; So.init(S, DM, F.G, (int)blockIdx.x);
            pg8::EpiResid E{xin, wsf(P, WS_X1), DM};
            pg8::gemm_phase<pg8::EpiResid, pg8::StaticOrder, true, true>(F.lds + RING_OFF, g, So, E);
        } SEAM(pb + 6);
        if (IN(pb + 7)) { LFRAME; rms_rows<false>(Fl, wsf(P, WS_X1), P.g_mlp + (size_t)l * DM, wsb(P, WS_H), nullptr); } SEAM(pb + 7);
        if (IN(pb + 8)) {
            pg8::Gemm g{wsb(P, WS_H), wsb(P, wb + WO_UP), S, DFF, DM}; pg8::StaticOrder So; So.init(S, DFF, F.G, (int)blockIdx.x);
            pg8::EpiBf16<2> E{wsb(P, WS_U), DFF, nullptr, 0};
            pg8::gemm_phase<pg8::EpiBf16<2>, pg8::StaticOrder, true, true>(F.lds + RING_OFF, g, So, E);
        } SEAM(pb + 8);
        if (IN(pb + 9)) {
            pg8::Gemm g{wsb(P, WS_U), wsb(P, wb + WO_DN), S, DM, DFF}; pg8::StaticOrder So; So.init(S, DM, F.G, (int)blockIdx.x);
            pg8::EpiResid E{wsf(P, WS_X1), wsf(P, WS_X1), DM};
            pg8::gemm_phase<pg8::EpiResid, pg8::StaticOrder, true, true>(F.lds + RING_OFF, g, So, E);
        } SEAM(pb + 9);
    }
    if (IN(21)) { LFRAME; rms_rows<true>(Fl, wsf(P, WS_X1), P.g_final, nullptr, P.out); }
#undef IN
#undef SEAM
}

extern "C" void kernel_launch(void* const* d_in, const int* in_sizes, int n_in, void* d_out, int out_size, void* d_ws, size_t ws_size, hipStream_t stream) {
    static int grid = 0;
    if (grid == 0) {
        if (n_in != 15 || out_size != S * DM || ws_size < WS_END) { fprintf(stderr, "kernel_launch: unexpected shapes (n_in %d out %d ws %zu, need %zu)\n", n_in, out_size, ws_size, (size_t)WS_END); grid = -1; return; }
        int dev = 0, cus = 0, per_cu = 0;
        if (hipGetDevice(&dev) != hipSuccess || hipDeviceGetAttribute(&cus, hipDeviceAttributeMultiprocessorCount, dev) != hipSuccess) { grid = -1; return; }
        if (hipFuncSetAttribute((const void*)fwd_kernel, hipFuncAttributeMaxDynamicSharedMemorySize, LDS_BYTES) != hipSuccess) { fprintf(stderr, "kernel_launch: hipFuncSetAttribute failed\n"); grid = -1; return; }
        if (hipOccupancyMaxActiveBlocksPerMultiprocessor(&per_cu, (const void*)fwd_kernel, NWAVES * 64, LDS_BYTES) != hipSuccess || per_cu < 1) fprintf(stderr, "kernel_launch: occupancy query says %d\n", per_cu);
        (void)hipGetLastError();
        grid = cus;
    }
    if (grid < 0) return;
    if (hipMemsetAsync((char*)d_ws + WS_CTL, 0, CTL_ZERO_BYTES, stream) != hipSuccess) return;
    Args a{};
    for (int i = 0; i < 15; ++i) a.in[i] = (const float*)d_in[i];
    a.out = (float*)d_out; a.ws = (unsigned char*)d_ws;
    if (MK_N_LAUNCHES == 1) { a.ph_lo = 0; a.ph_hi = N_PHASES; hipLaunchKernelGGL(fwd_kernel, dim3(grid), dim3(NWAVES * 64), LDS_BYTES, stream, a); }
    else { for (int p = 0; p < N_PHASES; ++p) { a.ph_lo = p; a.ph_hi = p + 1; hipLaunchKernelGGL(fwd_kernel, dim3(grid), dim3(NWAVES * 64), LDS_BYTES, stream, a); } }
}
```

```cpp
#include <hip/hip_runtime.h>
#include <cstdio>
#include <cstdint>
namespace pg8 {
#define PG8_LAS __attribute__((address_space(3)))
typedef unsigned short bf16_t;
typedef short bf16x8 __attribute__((ext_vector_type(8)));
typedef float f32x4 __attribute__((ext_vector_type(4)));
typedef unsigned u32x4 __attribute__((ext_vector_type(4)));
constexpr int BM = 256, BK = 64, HALF = 128, HTB = HALF * BK * 2  , STAGE_BYTES = 8 * HTB, NXCD = 8, WGM = 8;

__host__ __device__ __forceinline__ int lds_byte(int r, int c) { const int st = (r >> 4) * 2 + (c >> 5), rr = r & 15, cc = c & 31, ob = rr * 64 + cc * 2; return st * 1024 + (ob ^ (((ob >> 9) & 1) << 5)); }
__host__ __device__ __forceinline__ void stage_rc(int b, int& R, int& C) { const int st = b / 1024, sb = b % 1024, swz = sb ^ (((sb >> 9) & 1) << 5); R = (st >> 1) * 16 + swz / 64; C = (st & 1) * 32 + (swz % 64) / 2; }
__host__ __device__ __forceinline__ int perm32(int rho) { const int n = rho >> 4, i = rho & 15; return 8 * (i >> 2) + 4 * n + (i & 3); }

struct Unit { int pm, pn, ty; };
struct Gemm { const bf16_t* A; const bf16_t* Bt; int M, N, K, lda, ldb; const bf16_t* A1; const bf16_t* B1; int K1; const bf16_t* A2; const bf16_t* B2; int K2; };

struct StaticOrder {
    int nM, nN, nwg, G, c;
    __host__ __device__ void init(int M, int N, int G_, int c_) { nM = M / BM; nN = N / BM; nwg = nM * nN; G = G_; c = c_; }
    __host__ __device__ bool next(int i, Unit& u) const {
        const long L = (long)i * G + c; if (L >= nwg) return false;
        int wgid = (int)L; { const int q = nwg / NXCD, r = nwg % NXCD, xcd = wgid % NXCD, off = wgid / NXCD; wgid = (xcd < r ? xcd * (q + 1) : r * (q + 1) + (xcd - r) * q) + off; }
        const int nig = WGM * nN, gid = wgid / nig, fm = gid * WGM, gsz = (nM - fm) < WGM ? (nM - fm) : WGM;
        u.pm = fm + ((wgid % nig) % gsz); u.pn = (wgid % nig) / gsz; u.ty = 0; return true;
    }
    __device__ __forceinline__ void a_ready(const Unit&) const {}
    __device__ __forceinline__ void done(const Unit&) const {}
};
struct MixOrder {
    int G, c, pn0;
    __device__ bool dec(int L, Unit& u) const {
        if (L < 64) { u.ty = 0; u.pm = L & 31; u.pn = pn0 + (L >> 5); return true; }
        if (L < 256) { const int r = L - 64; u.ty = 1; u.pm = r & 31; u.pn = r >> 5; return true; }
        if (L < 512) { const int r = L - 256; u.ty = 2; u.pm = r & 31; u.pn = r >> 5; return true; }
        return false; }
    __device__ bool next(int i, Unit& u) const {
        if (G == 256) { if (c < 64) return i == 0 ? dec(c, u) : false; const int r = c - 64; if (i == 0) return dec(64 + r, u); if (i == 1) return dec(256 + r, u); if (i == 2 && r < 64) return dec(256 + 192 + r, u); return false; }
        return dec(i * G + c, u); }
    __device__ __forceinline__ void a_ready(const Unit&) const {}
    __device__ __forceinline__ void done(const Unit&) const {}
};


__device__ __forceinline__ unsigned cvt_pk_bf16(float lo, float hi) { unsigned r; asm volatile("v_cvt_pk_bf16_f32 %0, %1, %2" : "=v"(r) : "v"(lo), "v"(hi)); return r; }
template <int ACT> struct EpiBf16 {
    static constexpr bool PERM = true, AFTER_DRAIN = false;
    bf16_t* O; int ldc; float* side; int side_col; const float* ss; float inv_n;
    bf16_t* O2; int ldc2; int ntile2; float* ssp; int hb_n; const float* ssr; int p0, np;
    __device__ __forceinline__ void operator()(const f32x4 (&acc)[2][2][4][2], const Unit& u, int wr, int wc, int fr, int fq) const {
        const int row0 = u.pm * BM + wr * 64 + fr; const int col0 = u.pn * BM + wc * 32 + 8 * fq;
#pragma unroll
        for (int ai = 0; ai < 2; ++ai)
#pragma unroll
            for (int m = 0; m < 4; ++m) { const int row = row0 + ai * HALF + m * 16; bf16_t* rowp = O + (size_t)row * ldc + col0;
                float rs = (ss != nullptr) ? __builtin_amdgcn_rsqf(ss[row] * inv_n + 1e-6f) : 1.f;
                if (ssr != nullptr) { const f32x4* pr = (const f32x4*)(ssr + (size_t)row * 44 + p0); f32x4 a = pr[0];
                    for (int q = 1; q < np / 4; ++q) a += pr[q];
                    rs = __builtin_amdgcn_rsqf(((a[0] + a[1]) + (a[2] + a[3])) * inv_n + 1e-6f); }
#pragma unroll
                for (int bj = 0; bj < 2; ++bj) { f32x4 v0 = acc[ai][bj][m][0] * rs, v1 = acc[ai][bj][m][1] * rs;
                    if (side != nullptr && col0 + bj * HALF == side_col) { *(f32x4*)(side + (size_t)row * 8) = v0; *(f32x4*)(side + (size_t)row * 8 + 4) = v1; }
                    if (ACT == 2) {
#pragma unroll
                        for (int e = 0; e < 4; ++e) { const float a = fmaxf(v0[e], 0.f), b = fmaxf(v1[e], 0.f); v0[e] = a * a; v1[e] = b * b; } }
                    u32x4 w; w.x = cvt_pk_bf16(v0[0], v0[1]); w.y = cvt_pk_bf16(v0[2], v0[3]); w.z = cvt_pk_bf16(v1[0], v1[1]); w.w = cvt_pk_bf16(v1[2], v1[3]);
                    *(u32x4*)(rowp + bj * HALF) = w;
                    if (O2 != nullptr && u.pn < ntile2) { *(u32x4*)(O2 + (size_t)row * ldc2 + col0 + bj * HALF) = w;
                        const int hb = 2 * u.pn + bj;
                        if (hb < hb_n) { float sq = (v0[0] * v0[0] + v0[1] * v0[1]) + (v0[2] * v0[2] + v0[3] * v0[3]) + (v1[0] * v1[0] + v1[1] * v1[1]) + (v1[2] * v1[2] + v1[3] * v1[3]);
                            sq += __shfl_xor(sq, 16); sq += __shfl_xor(sq, 32); if (fq == 0) ssp[(size_t)row * 44 + 4 * hb + wc] = sq; } } } }
    }
};
struct EpiMix {
    static constexpr bool PERM = true, AFTER_DRAIN = false;
    EpiBf16<0> e0, e1, e2;
    __device__ __forceinline__ void operator()(const f32x4 (&acc)[2][2][4][2], const Unit& u, int wr, int wc, int fr, int fq) const {
        if (u.ty == 0) e0(acc, u, wr, wc, fr, fq); else if (u.ty == 1) e1(acc, u, wr, wc, fr, fq); else e2(acc, u, wr, wc, fr, fq);
    }
};
struct EpiResid {
    static constexpr bool PERM = true, AFTER_DRAIN = false;
    const float* R; float* O; int ldc; bf16_t* XB; float* ssq;
    __device__ __forceinline__ void operator()(const f32x4 (&acc)[2][2][4][2], const Unit& u, int wr, int wc, int fr, int fq) const {
        const int row0 = u.pm * BM + wr * 64 + fr; const int col0 = u.pn * BM + wc * 32 + 8 * fq;
#pragma unroll
        for (int ai = 0; ai < 2; ++ai)
#pragma unroll
            for (int m = 0; m < 4; ++m) { const int row = row0 + ai * HALF + m * 16; const size_t off = (size_t)row * ldc + col0; float sq = 0.f;
#pragma unroll
                for (int bj = 0; bj < 2; ++bj) { const f32x4 r0 = *(const f32x4*)(R + off + bj * HALF), r1 = *(const f32x4*)(R + off + bj * HALF + 4);
                    const f32x4 y0 = r0 + acc[ai][bj][m][0], y1 = r1 + acc[ai][bj][m][1];
                    *(f32x4*)(O + off + bj * HALF) = y0; *(f32x4*)(O + off + bj * HALF + 4) = y1;
                    if (XB != nullptr) { u32x4 w; w.x = cvt_pk_bf16(y0[0], y0[1]); w.y = cvt_pk_bf16(y0[2], y0[3]); w.z = cvt_pk_bf16(y1[0], y1[1]); w.w = cvt_pk_bf16(y1[2], y1[3]); *(u32x4*)(XB + off + bj * HALF) = w;
                        sq += (y0[0] * y0[0] + y0[1] * y0[1]) + (y0[2] * y0[2] + y0[3] * y0[3]) + (y1[0] * y1[0] + y1[1] * y1[1]) + (y1[2] * y1[2] + y1[3] * y1[3]); } }
                if (XB != nullptr) { sq += __shfl_xor(sq, 16); sq += __shfl_xor(sq, 32); if (fq == 0) atomicAdd(ssq + row, sq); } }
    }
};

template <class Epi, class Sched, bool ALIGN_EPI = false, bool SP2 = false>
__device__ __forceinline__ void gemm_phase(PG8_LAS unsigned char* lds, const Gemm g, const Sched& S, const Epi& E) {
    int tid_ = threadIdx.x; asm volatile("" : "+v"(tid_));
    const int tid = tid_, wid = __builtin_amdgcn_readfirstlane(tid >> 6), lane = tid & 63, wr = wid >> 2, wc = wid & 3, fr = lane & 15, fq = lane >> 4;
#define PG8_UA(u) ((const char*)((u).ty == 0 ? g.A : (u).ty == 1 ? g.A1 : g.A2))
#define PG8_UB(u) ((const char*)((u).ty == 0 ? g.Bt : (u).ty == 1 ? g.B1 : g.B2))
#define PG8_UK(u) ((u).ty == 0 ? g.K : (u).ty == 1 ? g.K1 : g.K2)
    unsigned voffA[2], voffB[2];
#pragma unroll
    for (int i = 0; i < 2; ++i) { int R, C; stage_rc(tid * 16 + i * 8192, R, C); const int Rb = Epi::PERM ? ((R & ~31) + perm32(R & 31)) : R;
        voffA[i] = (unsigned)(R * g.lda + C) * 2u; voffB[i] = (unsigned)(Rb * g.ldb + C) * 2u; }
    const size_t kstep = (size_t)(BK * 2);
    const size_t hstepA = (size_t)HALF * g.lda * 2, hstepB = (size_t)HALF * g.ldb * 2;
    const size_t tstepA = 2 * hstepA, tstepB = 2 * hstepB;
    const unsigned ldsw = (unsigned)wid * 1024u;
    const int aoff = lds_byte(wr * 64 + fr, fq * 8), boff = lds_byte(wc * 32 + fr, fq * 8);
#define PG8_SA(b, h) (((b) * 2 + (h)) * HTB)
#define PG8_SB(b, h) ((4 + (b) * 2 + (h)) * HTB)
#define PG8_STAGE(bufoff, gbase, voff) do { _Pragma("unroll") for (int _i = 0; _i < 2; ++_i) \
        __builtin_amdgcn_global_load_lds((const unsigned*)((const char*)(gbase) + (voff)[_i]), (PG8_LAS unsigned*)(lds + (bufoff) + ldsw + _i * 8192), 16, 0, 0); } while (0)
#define PG8_LDA(dst, b, h) do { _Pragma("unroll") for (int m = 0; m < 4; ++m) _Pragma("unroll") for (int k = 0; k < 2; ++k) dst[m][k] = *(const PG8_LAS bf16x8*)(lds + PG8_SA(b, h) + aoff + m * 2048 + k * 1024); } while (0)
#define PG8_LDB(dst, b, h) do { _Pragma("unroll") for (int n = 0; n < 2; ++n) _Pragma("unroll") for (int k = 0; k < 2; ++k) dst[n][k] = *(const PG8_LAS bf16x8*)(lds + PG8_SB(b, h) + boff + n * 2048 + k * 1024); } while (0)
#define PG8_MMA(ai, bj, At, Bt) do { __builtin_amdgcn_s_setprio(1); _Pragma("unroll") for (int m = 0; m < 4; ++m) _Pragma("unroll") for (int n = 0; n < 2; ++n) _Pragma("unroll") for (int k = 0; k < 2; ++k) \
        acc[ai][bj][m][n] = __builtin_amdgcn_mfma_f32_16x16x32_bf16(Bt[n][k], At[m][k], acc[ai][bj][m][n], 0, 0, 0); __builtin_amdgcn_s_setprio(0); } while (0)
#define PG8_WAIT_V(n) asm volatile("s_waitcnt vmcnt(" #n ")" ::: "memory")
#define PG8_WAIT_L(n) asm volatile("s_waitcnt lgkmcnt(" #n ")" ::: "memory")
#define PG8_BAR __builtin_amdgcn_s_barrier()
#define PG8_SCHED __builtin_amdgcn_sched_barrier(0)
    Unit cur, nxt; int ui = 0;
    if (!S.next(0, cur)) return;
    f32x4 acc[2][2][4][2];
#pragma unroll
    for (int a = 0; a < 2; ++a)
#pragma unroll
        for (int b = 0; b < 2; ++b)
#pragma unroll
            for (int m = 0; m < 4; ++m)
#pragma unroll
                for (int n = 0; n < 2; ++n) acc[a][b][m][n] = (f32x4){0.f, 0.f, 0.f, 0.f};
    bf16x8 At[4][2], B0[2][2], B1[2][2];
    const char* cA = PG8_UA(cur) + (size_t)cur.pm * tstepA; const char* cB = PG8_UB(cur) + (size_t)cur.pn * tstepB;
    S.a_ready(cur);
    if constexpr (SP2) {
        PG8_STAGE(PG8_SB(0, 0), cB, voffB); PG8_STAGE(PG8_SB(0, 1), cB + hstepB, voffB); PG8_STAGE(PG8_SA(0, 0), cA, voffA); PG8_STAGE(PG8_SA(0, 1), cA + hstepA, voffA);
        if (wr == 1) PG8_BAR;
        PG8_WAIT_V(2); PG8_BAR;
        PG8_STAGE(PG8_SB(1, 0), cB + kstep, voffB); PG8_STAGE(PG8_SA(1, 0), cA + kstep, voffA); PG8_STAGE(PG8_SB(1, 1), cB + hstepB + kstep, voffB);
        PG8_WAIT_V(6); PG8_BAR;
    } else {
        PG8_STAGE(PG8_SB(0, 0), cB, voffB); PG8_STAGE(PG8_SA(0, 0), cA, voffA); PG8_STAGE(PG8_SB(0, 1), cB + hstepB, voffB); PG8_STAGE(PG8_SA(0, 1), cA + hstepA, voffA);
        if (wr == 1) PG8_BAR;
        PG8_WAIT_V(4); PG8_BAR;
        PG8_STAGE(PG8_SB(1, 0), cB + kstep, voffB); PG8_STAGE(PG8_SA(1, 0), cA + kstep, voffA); PG8_STAGE(PG8_SB(1, 1), cB + hstepB + kstep, voffB);
        PG8_WAIT_V(6); PG8_BAR;
    }
    for (;;) {
        const bool has_next = S.next(ui + 1, nxt);
        const char* nA = has_next ? PG8_UA(nxt) + (size_t)nxt.pm * tstepA : cA; const char* nB = has_next ? PG8_UB(nxt) + (size_t)nxt.pn * tstepB : cB;
        const int nt = PG8_UK(cur) / BK;
        for (int t = 0; t < nt; t += 2) {
            const bool last = (t == nt - 2);
            const char* a1 = cA + (size_t)(t + 1) * kstep;
            const char* a2 = last ? nA : cA + (size_t)(t + 2) * kstep; const char* b2 = last ? nB : cB + (size_t)(t + 2) * kstep;
            const char* a3 = a2 + kstep; const char* b3 = b2 + kstep;
            if (last && has_next) S.a_ready(nxt);
            if constexpr (SP2) {
            PG8_LDB(B0, 0, 0); PG8_LDB(B1, 0, 1); PG8_SCHED; PG8_LDA(At, 0, 0); PG8_STAGE(PG8_SA(1, 1), a1 + hstepA, voffA);
            PG8_WAIT_V(8); PG8_WAIT_L(0); PG8_BAR; PG8_MMA(0, 0, At, B0); PG8_MMA(0, 1, At, B1); PG8_BAR; PG8_SCHED;
            PG8_LDA(At, 0, 1); PG8_STAGE(PG8_SB(0, 0), b2, voffB); PG8_STAGE(PG8_SB(0, 1), b2 + hstepB, voffB); PG8_STAGE(PG8_SA(0, 0), a2, voffA);
            PG8_WAIT_V(8); PG8_WAIT_L(0); PG8_BAR; PG8_MMA(1, 0, At, B0); PG8_MMA(1, 1, At, B1); PG8_BAR; PG8_SCHED;
            PG8_LDB(B0, 1, 0); PG8_LDB(B1, 1, 1); PG8_SCHED; PG8_LDA(At, 1, 0); PG8_STAGE(PG8_SA(0, 1), a2 + hstepA, voffA);
            PG8_WAIT_V(8); PG8_WAIT_L(0); PG8_BAR; PG8_MMA(0, 0, At, B0); PG8_MMA(0, 1, At, B1); PG8_BAR; PG8_SCHED;
            PG8_LDA(At, 1, 1); PG8_STAGE(PG8_SB(1, 0), b3, voffB); PG8_STAGE(PG8_SB(1, 1), b3 + hstepB, voffB); PG8_STAGE(PG8_SA(1, 0), a3, voffA);
            PG8_WAIT_V(8); PG8_WAIT_L(0); PG8_BAR; PG8_MMA(1, 0, At, B0); PG8_MMA(1, 1, At, B1); PG8_BAR; PG8_SCHED;
            } else {
            PG8_LDB(B0, 0, 0); PG8_SCHED; PG8_LDA(At, 0, 0); PG8_STAGE(PG8_SA(1, 1), a1 + hstepA, voffA);
            PG8_WAIT_L(8); PG8_BAR; PG8_WAIT_L(0); PG8_MMA(0, 0, At, B0); PG8_BAR; PG8_SCHED;
            PG8_LDB(B1, 0, 1); PG8_STAGE(PG8_SB(0, 0), b2, voffB);
            PG8_BAR; PG8_WAIT_L(0); PG8_MMA(0, 1, At, B1); PG8_BAR;
            PG8_LDA(At, 0, 1); PG8_STAGE(PG8_SA(0, 0), a2, voffA);
            PG8_BAR; PG8_WAIT_L(0); PG8_MMA(1, 0, At, B0); PG8_BAR; PG8_SCHED;
            PG8_STAGE(PG8_SB(0, 1), b2 + hstepB, voffB);
            PG8_WAIT_V(6); PG8_BAR; PG8_MMA(1, 1, At, B1); PG8_BAR;
            PG8_LDB(B0, 1, 0); PG8_SCHED; PG8_LDA(At, 1, 0); PG8_STAGE(PG8_SA(0, 1), a2 + hstepA, voffA);
            PG8_WAIT_L(8); PG8_BAR; PG8_WAIT_L(0); PG8_MMA(0, 0, At, B0); PG8_BAR; PG8_SCHED;
            PG8_LDB(B1, 1, 1); PG8_STAGE(PG8_SB(1, 0), b3, voffB);
            PG8_BAR; PG8_WAIT_L(0); PG8_MMA(0, 1, At, B1); PG8_BAR;
            PG8_LDA(At, 1, 1); PG8_STAGE(PG8_SA(1, 0), a3, voffA);
            PG8_BAR; PG8_WAIT_L(0); PG8_MMA(1, 0, At, B0); PG8_BAR; PG8_SCHED;
            PG8_STAGE(PG8_SB(1, 1), b3 + hstepB, voffB);
            PG8_WAIT_V(6); PG8_BAR; PG8_MMA(1, 1, At, B1); PG8_BAR;
            }
        }
        if constexpr (ALIGN_EPI) { if (wr == 0) PG8_BAR; }
        if constexpr (!Epi::AFTER_DRAIN) { E(acc, cur, wr, wc, fr, fq); S.done(cur); }
        if (!has_next) break;
#pragma unroll
        for (int a = 0; a < 2; ++a)
#pragma unroll
            for (int b = 0; b < 2; ++b)
#pragma unroll
                for (int m = 0; m < 4; ++m)
#pragma unroll
                    for (int n = 0; n < 2; ++n) acc[a][b][m][n] = (f32x4){0.f, 0.f, 0.f, 0.f};
        cur = nxt; cA = nA; cB = nB; ++ui;
        if constexpr (ALIGN_EPI) { if (wr == 1) PG8_BAR; }
    }
    PG8_WAIT_V(0);
    if constexpr (!ALIGN_EPI) { if (wr == 0) PG8_BAR; }
    PG8_BAR;
    if constexpr (Epi::AFTER_DRAIN) { E.fused(acc, cur, wr, wc, fr, fq, lds, wid, lane); S.done(cur); }
#undef PG8_UA
#undef PG8_UB
#undef PG8_UK
#undef PG8_SA
#undef PG8_SB
#undef PG8_STAGE
#undef PG8_LDA
#undef PG8_LDB
#undef PG8_MMA
#undef PG8_WAIT_V
#undef PG8_WAIT_L
#undef PG8_BAR
#undef PG8_SCHED
}
}
#define GAS __attribute__((address_space(1)))
#define LAS __attribute__((address_space(3)))
typedef unsigned short bf16;
typedef unsigned v4u __attribute__((ext_vector_type(4)));
typedef float f32x4 __attribute__((ext_vector_type(4)));
typedef short bf16x8 __attribute__((ext_vector_type(8)));
typedef GAS unsigned gu32;
typedef GAS unsigned long long gu64;
#define RLX_AGENT __ATOMIC_RELAXED, __HIP_MEMORY_SCOPE_AGENT
#define LDS_WAIT() asm volatile("s_waitcnt lgkmcnt(0)" ::: "memory")
#define VM_WAIT() asm volatile("s_waitcnt vmcnt(0)" ::: "memory")
__device__ __forceinline__ unsigned long long rt() { return __builtin_amdgcn_s_memrealtime(); }
__device__ __forceinline__ unsigned f2bf(float f) { unsigned u = __builtin_bit_cast(unsigned, f); return (u + 0x7fffu + ((u >> 16) & 1u)) >> 16; }
__device__ __forceinline__ unsigned pk2(float lo, float hi) { return f2bf(lo) | (f2bf(hi) << 16); }

#define XB_TMO      128
#define XB_XCNT(j)  (256  + 64 * (j))
#define XB_XSUB(j)  (1280 + 64 * (j))
#define XB_XGEN(j)  (2304 + 64 * (j))
#define XB_TOP      3328
#define XB_TOPGEN   3392
#define XCD_BAR_WORDS 3456
#define XB_SPIN_CAP (1u << 18)

__device__ __forceinline__ unsigned xb_ld(unsigned* p)              { return __hip_atomic_load(p, __ATOMIC_RELAXED, __HIP_MEMORY_SCOPE_AGENT); }
__device__ __forceinline__ unsigned xb_add(unsigned* p, unsigned v) { return __hip_atomic_fetch_add(p, v, __ATOMIC_RELAXED, __HIP_MEMORY_SCOPE_AGENT); }
__device__ __forceinline__ unsigned xb_xcc_id() { return (unsigned)__builtin_amdgcn_s_getreg((3 << 11) | 20) & 0xFu; }
#define XB_SPIN(cond, bar) do { unsigned _sp = 0; while (cond) { __builtin_amdgcn_s_sleep(1); \
    if ((++_sp & 255u) == 0u) { if (xb_ld(&(bar)[XB_TMO])) break; if (_sp > XB_SPIN_CAP) { atomicAdd(&(bar)[XB_TMO], 1u); break; } } } } while (0)

struct XcdBarrier {
    unsigned* bar; unsigned x;
    volatile LAS unsigned* st;
};

__device__ __forceinline__ XcdBarrier xcd_barrier_post(unsigned* bar, volatile LAS unsigned* st) {
    XcdBarrier b; b.bar = bar; b.x = xb_xcc_id(); b.st = st;
    if (threadIdx.x == 0) (void)xb_add(&bar[XB_XCNT(b.x)], 1u);
    return b;
}
__device__ __forceinline__ void xcd_barrier_complete(unsigned* bar, unsigned x, unsigned& nloc, unsigned& nx) {
    const unsigned G = gridDim.x * gridDim.y * gridDim.z;
    unsigned sum, cnt, mine, sp = 0u;
    for (;;) {
        sum = 0u; cnt = 0u; mine = 0u;
#pragma unroll
        for (unsigned j = 0; j < 16; ++j) { const unsigned c = xb_ld(&bar[XB_XCNT(j)]); sum += c; cnt += (c > 0u) ? 1u : 0u; mine = (j == x) ? c : mine; }
        if (sum == G) break;
        __builtin_amdgcn_s_sleep(1);
        if ((++sp & 255u) == 0u) { if (xb_ld(&bar[XB_TMO])) break; if (sp > XB_SPIN_CAP) { atomicAdd(&bar[XB_TMO], 1u); break; } }
    }
    nloc = mine > 0u ? mine : 1u; nx = cnt > 0u ? cnt : 1u;
}

__device__ __forceinline__ void xcd_barrier(const XcdBarrier& b) {
    asm volatile("s_waitcnt vmcnt(0)" ::: "memory");
    __syncthreads();
    if (threadIdx.x == 0) {
        unsigned* bar = b.bar;
        __builtin_amdgcn_s_waitcnt(0);
        unsigned nloc = b.st[0], nx = b.st[1];
        if (nloc == 0u) { xcd_barrier_complete(bar, b.x, nloc, nx); b.st[0] = nloc; b.st[1] = nx; }
        const unsigned old = xb_add(&bar[XB_XSUB(b.x)], 1u);
        const unsigned gen = old / nloc;
        if (old + 1u == (gen + 1u) * nloc) {
            __builtin_amdgcn_fence(__ATOMIC_RELEASE, "agent");
            asm volatile("s_waitcnt vmcnt(0)" ::: "memory");
            const unsigned og = xb_add(&bar[XB_TOP], 1u);
            const unsigned tg = og / nx;
            if (og + 1u == (tg + 1u) * nx) xb_add(&bar[XB_TOPGEN], 1u);
            else XB_SPIN(xb_ld(&bar[XB_TOPGEN]) == tg, bar);
            __builtin_amdgcn_fence(__ATOMIC_ACQUIRE, "agent");
            xb_add(&bar[XB_XGEN(b.x)], 1u);
            asm volatile("s_waitcnt vmcnt(0)" ::: "memory");
        } else {
            XB_SPIN(xb_ld(&bar[XB_XGEN(b.x)]) == gen, bar);
            __builtin_amdgcn_fence(__ATOMIC_ACQUIRE, "agent");
            asm volatile("s_waitcnt vmcnt(0)" ::: "memory");
        }
    }
    __syncthreads();
}

constexpr int NWAVES = 8;
constexpr int S = 8192, DM = 4096, NP = 10752, INC = 10696, QLR = 896, KVLR = 512, NQA = 1536, NKVU = 2048, DFF = 16384, NH = 8, HD = 128, GW = 1024;
constexpr int NMAIN = 10240;
constexpr int PC_CQ = 0, PC_CKV = 896, PC_KR = 1408, PC_F = 1472, PC_B = 1536, PC_C = 4608, PC_D = 7680;
constexpr float EPS = 1e-6f;
constexpr float LOG2E = 1.4426950408889634f, LN2 = 0.6931471805599453f;
constexpr size_t MiB = 1u << 20;
constexpr size_t WS_CTL = 0, CTL_ZERO_BYTES = 1 * MiB;
constexpr size_t WS_COS64 = 1 * MiB, WS_SIN64 = 2 * MiB, WS_COS32 = 3 * MiB, WS_SIN32 = 3 * MiB + 512 * 1024;
constexpr size_t WS_PF = 4 * MiB, WS_LOGF = 4 * MiB + 256 * 1024, WS_CK = 4 * MiB + 512 * 1024, WS_LSE = 5 * MiB, WS_LSEA = 5 * MiB + 768 * 1024;
constexpr size_t WS_W0 = 8 * MiB, WS_WSTRIDE = 378 * MiB;
constexpr size_t WO_IN = 0, WO_UQ = 84 * MiB, WO_UKV = 87 * MiB, WO_O = 89 * MiB, WO_UP = 121 * MiB, WO_DN = 249 * MiB;
constexpr size_t WS_H = 764 * MiB, WS_PROJ = 828 * MiB, WS_CQ = 996 * MiB, WS_CKV = 1010 * MiB, WS_QA = 1018 * MiB, WS_KVU = 1042 * MiB, WS_KR = 1074 * MiB;
constexpr size_t WS_O = 1075 * MiB, WS_OB = 1139 * MiB, WS_X1 = 1187 * MiB, WS_U = 1315 * MiB, WS_XB = 1571 * MiB, WS_PA = 1635 * MiB, WS_WUP2 = 1667 * MiB  , WS_END = 1723 * MiB;
static_assert((size_t)NP * DM * 2 <= 84 * MiB && (size_t)S * NP * 2 <= 168 * MiB && (size_t)S * DFF * 2 <= 256 * MiB, "map");
constexpr int CW_TMO = 0, CW_CODE = 1, CW_BAR = 4096, CW_QUEUE = 16384, CW_SS = 65536, CW_KN = 61440, CW_SSQ = 131072;
constexpr int RING_OFF = 0, RING_BYTES = 131072;
constexpr int LDSCTL_OFF = RING_BYTES, MISC_OFF = LDSCTL_OFF + 320;
constexpr int LDS_BYTES = 147456;

struct Frame {
    LAS unsigned char* lds;
    volatile LAS unsigned* MISC;
    gu32* ctl;
    int tid, lane, wave, G;
};

__device__ __forceinline__ float wave_sum(float v) {
#pragma unroll
    for (int o = 1; o < 64; o <<= 1) v += __shfl_xor(v, o);
    return v;
}
__device__ __forceinline__ int opaque(int v) { asm volatile("" : "+v"(v)); return v; }
#define LFRAME Frame Fl = F; Fl.tid = opaque(F.tid); Fl.lane = Fl.tid & 63; Fl.wave = __builtin_amdgcn_readfirstlane(Fl.tid >> 6)
__device__ __forceinline__ float bf2f(unsigned short b) { return __builtin_bit_cast(float, (unsigned)b << 16); }
__device__ __forceinline__ float bflo(unsigned w) { return __builtin_bit_cast(float, w << 16); }
__device__ __forceinline__ float bfhi(unsigned w) { return __builtin_bit_cast(float, w & 0xffff0000u); }

__device__ __forceinline__ unsigned cvtpk_rne(float lo, float hi) { unsigned r; asm volatile("v_cvt_pk_bf16_f32 %0, %1, %2" : "=v"(r) : "v"(lo), "v"(hi)); return r; }
__device__ __forceinline__ void p0_item64(const float* W, int K, int N, bf16* WT, const float* gk, int item, int nblk, int lane, int ldw = 0, bool win_layout = false) {
    const int kb = item / nblk, nb = item - kb * nblk, kq = lane >> 4, c = lane & 15;
    const int kbase = 64 * kb + 16 * kq, n = 64 * nb + 4 * c; const bool ok = n < N;
    const int nbd = !win_layout ? nb : (nb <= 22 ? nb : (nb <= 166 ? nb + 1 : 23)); const int nd = 64 * nbd + 4 * c;
    f32x4 v[16];
    const float* src = W + (size_t)kbase * N + n;
#pragma unroll
    for (int i = 0; i < 16; ++i) v[i] = ok ? __builtin_nontemporal_load((const GAS f32x4*)(src + (size_t)i * N)) : (f32x4){0.f, 0.f, 0.f, 0.f};
    if (gk != nullptr) {
#pragma unroll
        for (int i = 0; i < 4; ++i) { const f32x4 g = *(const GAS f32x4*)(gk + kbase + 4 * i); v[4 * i] *= g.x; v[4 * i + 1] *= g.y; v[4 * i + 2] *= g.z; v[4 * i + 3] *= g.w; }
    }
#pragma unroll
    for (int j = 0; j < 4; ++j) {
        v4u lo, hi;
        lo.x = cvtpk_rne(v[0][j], v[1][j]); lo.y = cvtpk_rne(v[2][j], v[3][j]); lo.z = cvtpk_rne(v[4][j], v[5][j]); lo.w = cvtpk_rne(v[6][j], v[7][j]);
        hi.x = cvtpk_rne(v[8][j], v[9][j]); hi.y = cvtpk_rne(v[10][j], v[11][j]); hi.z = cvtpk_rne(v[12][j], v[13][j]); hi.w = cvtpk_rne(v[14][j], v[15][j]);
        bf16* dst = WT + (size_t)(nd + j) * (ldw ? ldw : K) + kbase;
        *(GAS v4u*)dst = lo; *(GAS v4u*)(dst + 8) = hi;
    }
}
__device__ __forceinline__ void sincos_d(double a, float& sn, float& cs) {
    const double k = __builtin_rint(a * 0.15915494309189535);
    double r = __builtin_fma(-k, 6.283185307179586, a); r = __builtin_fma(-k, 2.4492935982947064e-16, r);
    const double q = __builtin_rint(r * 0.6366197723675814);
    double x = __builtin_fma(-q, 1.5707963267948966, r); x = __builtin_fma(-q, 6.123233995736766e-17, x);
    const double x2 = x * x;
    double sp = 1.0 / 6227020800.0; sp = sp * x2 - 1.0 / 39916800.0; sp = sp * x2 + 1.0 / 362880.0; sp = sp * x2 - 1.0 / 5040.0; sp = sp * x2 + 1.0 / 120.0; sp = sp * x2 - 1.0 / 6.0; sp = sp * x2 * x + x;
    double cp = -1.0 / 87178291200.0; cp = cp * x2 + 1.0 / 479001600.0; cp = cp * x2 - 1.0 / 3628800.0; cp = cp * x2 + 1.0 / 40320.0; cp = cp * x2 - 1.0 / 720.0; cp = cp * x2 + 1.0 / 24.0; cp = cp * x2 - 0.5; cp = cp * x2 + 1.0;
    const int qi = ((int)q) & 3;
    const double s = (qi == 0) ? sp : (qi == 1) ? cp : (qi == 2) ? -sp : -cp;
    const double c = (qi == 0) ? cp : (qi == 1) ? -sp : (qi == 2) ? -cp : sp;
    sn = (float)s; cs = (float)c;
}
__device__ __forceinline__ double powi_d(double c, int i) { double r = 1.0, b = c; for (int e = 0; e < 5; ++e) { if (i & (1 << e)) r *= b; b *= b; } return r; }

struct Ptrs {
    const float *x, *g_attn, *w_in, *g_q, *g_kv, *w_uq, *w_uk, *w_uv, *b_f, *g_out, *w_o, *g_mlp, *w_up, *w_down, *g_final;
    float* out; unsigned char* ws;
};
__device__ __forceinline__ bf16* wsb(const Ptrs& P, size_t off) { return (bf16*)(P.ws + off); }
__device__ __forceinline__ float* wsf(const Ptrs& P, size_t off) { return (float*)(P.ws + off); }

__device__ __forceinline__ void p0_prologue(Frame& F, const Ptrs& P, int lsel, int part) {
    const int gw = blockIdx.x * NWAVES + F.wave, NGW = F.G * NWAVES;
    constexpr int I_IN = (DM / 64) * (NP / 64), I_UQ = (QLR / 64) * (NQA / 64), I_UK = (KVLR / 64) * (GW / 64), I_O = (DM / 64) * (DM / 64), I_UP = (DM / 64) * (DFF / 64), I_DN = (DFF / 64) * (DM / 64);
    constexpr int PER = I_IN + I_UQ + 2 * I_UK + I_O + I_UP + I_DN;
    constexpr int P0N = I_IN + I_UQ + 2 * I_UK;
    const int lo_ = (part == 0) ? 0 : (part == 1) ? P0N : (part == 2) ? P0N + I_O : P0N + I_O + I_UP, hi_ = (part == 0) ? P0N : (part == 1) ? P0N + I_O : (part == 2) ? P0N + I_O + I_UP : PER;
    for (int it = lo_ + gw; it < hi_; it += NGW) {
        const int l = lsel; int r = it; const size_t wb = WS_W0 + (size_t)l * WS_WSTRIDE;
        if (r < I_IN) { p0_item64(P.w_in + (size_t)l * DM * INC, DM, INC, wsb(P, wb + WO_IN), P.g_attn + (size_t)l * DM, r, NP / 64, F.lane, 0, true); continue; } r -= I_IN;
        if (r < I_UQ) { p0_item64(P.w_uq + (size_t)l * QLR * NQA, QLR, NQA, wsb(P, WS_WUP2 + (size_t)l * 28 * MiB), P.g_q + (size_t)l * QLR, r, NQA / 64, F.lane, DM); continue; } r -= I_UQ;
        if (r < I_UK) { p0_item64(P.w_uk + (size_t)l * KVLR * GW, KVLR, GW, wsb(P, WS_WUP2 + (size_t)l * 28 * MiB + 12 * MiB), P.g_kv + (size_t)l * KVLR, r, GW / 64, F.lane, DM); continue; } r -= I_UK;
        if (r < I_UK) { p0_item64(P.w_uv + (size_t)l * KVLR * GW, KVLR, GW, wsb(P, WS_WUP2 + (size_t)l * 28 * MiB + 12 * MiB) + (size_t)GW * DM, P.g_kv + (size_t)l * KVLR, r, GW / 64, F.lane, DM); continue; } r -= I_UK;
        if (r < I_O) { p0_item64(P.w_o + (size_t)l * DM * DM, DM, DM, wsb(P, wb + WO_O), nullptr, r, DM / 64, F.lane); continue; } r -= I_O;
        if (r < I_UP) { p0_item64(P.w_up + (size_t)l * DM * DFF, DM, DFF, wsb(P, wb + WO_UP), P.g_mlp + (size_t)l * DM, r, DFF / 64, F.lane); continue; } r -= I_UP;
        p0_item64(P.w_down + (size_t)l * DFF * DM, DFF, DM, wsb(P, wb + WO_DN), nullptr, r, DM / 64, F.lane);
    }
    if (lsel == 0 && part == 0) {
    { float* ss0 = (float*)(F.ctl + CW_SS); bf16* XB = wsb(P, WS_XB);
      for (int m = gw; m < S; m += NGW) {
        const GAS f32x4* xr = (const GAS f32x4*)(P.x + (size_t)m * DM) + F.lane; GAS unsigned long long* o8 = (GAS unsigned long long*)(XB + (size_t)m * DM) + F.lane; float sq = 0.f;
#pragma unroll
        for (int j = 0; j < 16; ++j) { const f32x4 v = xr[64 * j]; sq += (v.x * v.x + v.y * v.y) + (v.z * v.z + v.w * v.w); o8[64 * j] = (unsigned long long)cvtpk_rne(v.x, v.y) | ((unsigned long long)cvtpk_rne(v.z, v.w) << 32); }
        sq = wave_sum(sq); if (F.lane == 0) ss0[m] = sq; } }
    const int gt = blockIdx.x * (NWAVES * 64) + F.tid, NGT = F.G * NWAVES * 64;
    for (int e = gt; e < S * 48; e += NGT) {
        const int pos = e / 48, j = e % 48;
        float sn, cs;
        if (j < 32) { const double inv = powi_d(0.6636012376960885, j); sincos_d((double)pos * inv, sn, cs); wsf(P, WS_COS64)[pos * 32 + j] = cs; wsf(P, WS_SIN64)[pos * 32 + j] = sn; }
        else { const int i = j - 32; const double inv = powi_d(0.44036660267178046, i); sincos_d((double)pos * inv, sn, cs); wsf(P, WS_COS32)[pos * 16 + i] = cs; wsf(P, WS_SIN32)[pos * 16 + i] = sn; }
    }
    }
}

__device__ __forceinline__ void conv_range(Frame& F, const Ptrs& P, int lsel, int it_lo, int it_hi) {
    constexpr int I_IN = (DM / 64) * (NP / 64), I_UQ = (QLR / 64) * (NQA / 64), I_UK = (KVLR / 64) * (GW / 64), I_O = (DM / 64) * (DM / 64), I_UP = (DM / 64) * (DFF / 64);
    const int l = lsel; const size_t wb = WS_W0 + (size_t)l * WS_WSTRIDE;
    for (int it = it_lo + F.wave; it < it_hi; it += NWAVES) {
        int r = it;
        if (r < I_IN) { p0_item64(P.w_in + (size_t)l * DM * INC, DM, INC, wsb(P, wb + WO_IN), P.g_attn + (size_t)l * DM, r, NP / 64, F.lane, 0, true); continue; } r -= I_IN;
        if (r < I_UQ) { p0_item64(P.w_uq + (size_t)l * QLR * NQA, QLR, NQA, wsb(P, WS_WUP2 + (size_t)l * 28 * MiB), P.g_q + (size_t)l * QLR, r, NQA / 64, F.lane, DM); continue; } r -= I_UQ;
        if (r < I_UK) { p0_item64(P.w_uk + (size_t)l * KVLR * GW, KVLR, GW, wsb(P, WS_WUP2 + (size_t)l * 28 * MiB + 12 * MiB), P.g_kv + (size_t)l * KVLR, r, GW / 64, F.lane, DM); continue; } r -= I_UK;
        if (r < I_UK) { p0_item64(P.w_uv + (size_t)l * KVLR * GW, KVLR, GW, wsb(P, WS_WUP2 + (size_t)l * 28 * MiB + 12 * MiB) + (size_t)GW * DM, P.g_kv + (size_t)l * KVLR, r, GW / 64, F.lane, DM); continue; } r -= I_UK;
        if (r < I_O) { p0_item64(P.w_o + (size_t)l * DM * DM, DM, DM, wsb(P, wb + WO_O), nullptr, r, DM / 64, F.lane); continue; } r -= I_O;
        if (r < I_UP) { p0_item64(P.w_up + (size_t)l * DM * DFF, DM, DFF, wsb(P, wb + WO_UP), P.g_mlp + (size_t)l * DM, r, DFF / 64, F.lane); continue; } r -= I_UP;
        p0_item64(P.w_down + (size_t)l * DFF * DM, DFF, DM, wsb(P, wb + WO_DN), nullptr, r, DM / 64, F.lane);
    }
}

template <bool F32OUT>
__device__ __forceinline__ void rms_rows(Frame& F, const float* X, const float* g, bf16* ob, float* of) {
    const int gw = blockIdx.x * NWAVES + F.wave, NGW = F.G * NWAVES;
    for (int m = gw; m < S; m += NGW) {
        const GAS f32x4* xr = (const GAS f32x4*)(X + (size_t)m * DM) + F.lane;
        f32x4 v[16]; float s = 0.f;
#pragma unroll
        for (int j = 0; j < 16; ++j) { v[j] = xr[64 * j]; s += (v[j].x * v[j].x + v[j].y * v[j].y) + (v[j].z * v[j].z + v[j].w * v[j].w); }
        const float rstd = 1.f / sqrtf(wave_sum(s) * (1.f / DM) + EPS);
        const GAS f32x4* gr = (const GAS f32x4*)g + F.lane;
        if (F32OUT) { GAS f32x4* o = (GAS f32x4*)(of + (size_t)m * DM) + F.lane;
#pragma unroll
            for (int j = 0; j < 16; ++j) { const f32x4 gg = gr[64 * j]; o[64 * j] = v[j] * rstd * gg; } }
        else { GAS unsigned long long* o8 = (GAS unsigned long long*)(ob + (size_t)m * DM) + F.lane;
#pragma unroll
            for (int j = 0; j < 16; ++j) { const f32x4 gg = gr[64 * j]; const f32x4 y = v[j] * rstd * gg;
                o8[64 * j] = (unsigned long long)pk2(y.x, y.y) | ((unsigned long long)pk2(y.z, y.w) << 32); } }
    }
}

__device__ __forceinline__ void postproj_rows(Frame& F, const Ptrs& P, int l, int b0, int nb_) {
    const int gw = ((int)blockIdx.x - b0) * NWAVES + F.wave, NGW = nb_ * NWAVES, lane = F.lane;
    bf16* PROJ = wsb(P, WS_PROJ); bf16* CQ = wsb(P, WS_CQ); bf16* CKV = wsb(P, WS_CKV); bf16* KR = wsb(P, WS_KR);
    const float* gq = P.g_q + l * QLR; const float* gkv = P.g_kv + l * KVLR; const float* bfp = P.b_f + l * NH;
    const float* C64 = wsf(P, WS_COS64); const float* S64 = wsf(P, WS_SIN64); const float* C32 = wsf(P, WS_COS32); const float* S32 = wsf(P, WS_SIN32);
    float knmax[2] = {0.f, 0.f};
    for (int m = gw; m < S; m += NGW) {
        bf16* prow = PROJ + (size_t)m * NP;
        if (lane < 32) {
            const float t1 = bf2f(prow[PC_KR + lane]), t2 = bf2f(prow[PC_KR + 32 + lane]); const float c = C64[m * 32 + lane], sn = S64[m * 32 + lane];
            KR[(size_t)m * 64 + lane] = (bf16)f2bf(t1 * c - t2 * sn); KR[(size_t)m * 64 + 32 + lane] = (bf16)f2bf(t1 * sn + t2 * c);
        }
        {
            const int chunk = lane >> 2, part = lane & 3; bf16* cp = prow + PC_B + (chunk >> 3) * GW + (chunk & 7) * HD + 4 * part;
            const unsigned long long w1 = *(const GAS unsigned long long*)cp, w2 = *(const GAS unsigned long long*)(cp + 16);
            const f32x4 c = *(const GAS f32x4*)(C32 + (size_t)m * 16 + 4 * part), sn = *(const GAS f32x4*)(S32 + (size_t)m * 16 + 4 * part);
            const float a0 = bflo((unsigned)w1), a1 = bfhi((unsigned)w1), a2 = bflo((unsigned)(w1 >> 32)), a3 = bfhi((unsigned)(w1 >> 32));
            const float b0 = bflo((unsigned)w2), b1 = bfhi((unsigned)w2), b2 = bflo((unsigned)(w2 >> 32)), b3 = bfhi((unsigned)(w2 >> 32));
            *(GAS unsigned long long*)cp = (unsigned long long)pk2(a0 * c.x - b0 * sn.x, a1 * c.y - b1 * sn.y) | ((unsigned long long)pk2(a2 * c.z - b2 * sn.z, a3 * c.w - b3 * sn.w) << 32);
            *(GAS unsigned long long*)(cp + 16) = (unsigned long long)pk2(a0 * sn.x + b0 * c.x, a1 * sn.y + b1 * c.y) | ((unsigned long long)pk2(a2 * sn.z + b2 * c.z, a3 * sn.w + b3 * c.w) << 32);
        }
        {
#pragma unroll
            for (int c = 0; c < 2; ++c) { const v4u w = *(const GAS v4u*)(prow + PC_D + GW + c * 512 + 8 * lane);
                float sq = bflo(w.x) * bflo(w.x) + bfhi(w.x) * bfhi(w.x) + bflo(w.y) * bflo(w.y) + bfhi(w.y) * bfhi(w.y) + bflo(w.z) * bflo(w.z) + bfhi(w.z) * bfhi(w.z) + bflo(w.w) * bflo(w.w) + bfhi(w.w) * bfhi(w.w);
                sq += __shfl_xor(sq, 1); sq += __shfl_xor(sq, 2); sq += __shfl_xor(sq, 4); sq += __shfl_xor(sq, 8);
                knmax[c] = fmaxf(knmax[c], sq); }
        }
    }
    {
        LAS float* red = (LAS float*)(F.lds + RING_OFF);
        if ((lane & 15) == 0) { red[F.wave * 8 + (lane >> 4)] = knmax[0]; red[F.wave * 8 + 4 + (lane >> 4)] = knmax[1]; }
        __syncthreads();
        if (F.tid < NH) { float mx = 0.f;
#pragma unroll
            for (int w = 0; w < NWAVES; ++w) mx = fmaxf(mx, red[w * 8 + F.tid]);
            __hip_atomic_fetch_max(F.ctl + CW_KN + 16 * (l & 1) + F.tid, __builtin_bit_cast(unsigned, mx), __ATOMIC_RELAXED, __HIP_MEMORY_SCOPE_AGENT); }
        __syncthreads();
    }
}

__device__ __forceinline__ void cumsum_head(Frame& F, const Ptrs& P, int h, int l) {
    const float* PFp = wsf(P, WS_PF); const float bfh = P.b_f[l * NH + h]; float* CK = wsf(P, WS_CK) + (size_t)h * S;
    LAS float* wt = (LAS float*)(F.lds + RING_OFF);
    float v[16]; float run = 0.f;
#pragma unroll
    for (int j = 0; j < 16; ++j) { const float z = PFp[(size_t)(16 * F.tid + j) * 8 + h] + bfh; run += fminf(z, 0.f) - log1pf(expf(-fabsf(z))); v[j] = run; }
    float inc = run;
#pragma unroll
    for (int o = 1; o < 64; o <<= 1) { const float t = __shfl_up(inc, o); if (F.lane >= o) inc += t; }
    if (F.lane == 63) wt[F.wave] = inc;
    __syncthreads();
    float base = inc - run;
    for (int w = 0; w < F.wave; ++w) base += wt[w];
#pragma unroll
    for (int j = 0; j < 16; ++j) CK[16 * F.tid + j] = base + v[j];
    __syncthreads();
}


namespace fa {
typedef short bf16x8 __attribute__((ext_vector_type(8)));
typedef short s16x4 __attribute__((ext_vector_type(4)));
typedef float f32x16 __attribute__((ext_vector_type(16)));
typedef float f32x4 __attribute__((ext_vector_type(4)));
typedef unsigned u32x4 __attribute__((ext_vector_type(4)));
constexpr int L_V = 0, L_K = 32768, L_KR = 65536, L_WS = 81920, L_BIAS = 83968, L_FLAG = 84480, L_ITEM = 84608;
constexpr int SHM = 16384;
#define FA_LP(T, off) ((LAS T*)(lds + (off)))
__device__ __forceinline__ int kswz(int row, int colB) { return row * 256 + (colB ^ ((row & 7) << 4)); }
__device__ __forceinline__ int krswz(int row, int colB) { return row * 128 + (colB ^ ((row & 7) << 4)); }
__device__ __forceinline__ int v_st(int k, int c) { const int kk = (k & ~0xC) | ((k & 4) << 1) | ((k & 8) >> 1); return ((kk >> 3) * 4 + (c >> 5)) * 512 + ((kk & 7) * 32 + (c & 31)) * 2; }
__device__ __forceinline__ int v_rd_base(int lane) { return ((lane & 3) << 3) | (((lane >> 2) & 3) << 6) | (((lane >> 4) & 1) << 5) | (((lane >> 5) & 1) << 8); }
constexpr int v_rd_off(int d0, int ks, int half) { return d0 * 512 + ks * 4096 + half * 2048; }
__device__ __forceinline__ int crow(int r, int hi) { return (r & 3) + 8 * (r >> 2) + 4 * hi; }
__device__ __forceinline__ unsigned cvtpk(float lo, float hi) { unsigned r; asm volatile("v_cvt_pk_bf16_f32 %0, %1, %2" : "=v"(r) : "v"(lo), "v"(hi)); return r; }
__device__ __forceinline__ float xsum(float v) { auto rr = __builtin_amdgcn_permlane32_swap(__float_as_uint(v), __float_as_uint(v), false, false); return __uint_as_float(rr[0]) + __uint_as_float(rr[1]); }
__device__ __forceinline__ float xmax(float v) { auto rr = __builtin_amdgcn_permlane32_swap(__float_as_uint(v), __float_as_uint(v), false, false); return fmaxf(__uint_as_float(rr[0]), __uint_as_float(rr[1])); }
#define FA_SBAR() __builtin_amdgcn_sched_barrier(0)

struct UnitRef {
    const bf16* Q; int qp;
    const bf16* K; int kp;
    const bf16* V; int vp;
    const bf16* KR;
    const float* CK;
    const float* COS; const float* SIN;
    bf16* O; int op;
    float* LSE; int lp;
    int P0;
    int jlo, jhi;
    float kn2;
};

template <int VAR>
__device__ __forceinline__ void attn_unit(LAS unsigned char* lds, const UnitRef& U, int tid) {
    constexpr int NQ = (VAR == 0) ? 12 : 8;
    constexpr float SCALE = (VAR == 0) ? 0.07216878364870323f : 0.08838834764831845f;
    constexpr float C2 = SCALE * 1.4426950408889634f;
    constexpr float THR2 = 8.f * 1.4426950408889634f;
    const int wid = __builtin_amdgcn_readfirstlane(tid >> 6), lane = tid & 63, r32 = lane & 31, hi = lane >> 5;
    const int W = (VAR == 1) ? 129 : 0x40000000;
    const int P0 = U.P0;
    const int j_lo = U.jlo, j_hi = U.jhi;
    const int qlo = P0 + wid * 32;
    const int qm = qlo + r32 - 4 * hi - (VAR == 2 ? 1 : 0);
    bf16x8 qr[NQ];
    { const bf16* qrow = U.Q + (size_t)(wid * 32 + r32) * U.qp + hi * 8;
#pragma unroll
      for (int d0 = 0; d0 < 8; ++d0) qr[d0] = *(const GAS bf16x8*)(qrow + d0 * 16);
      if constexpr (VAR == 0) {
          bf16x8 f[4];
#pragma unroll
          for (int d = 0; d < 4; ++d) f[d] = *(const GAS bf16x8*)(qrow + 128 + d * 16);
          const int pos = qlo + r32;
#pragma unroll
          for (int d = 0; d < 2; ++d) {
              const f32x4 c0 = *(const GAS f32x4*)(U.COS + (size_t)pos * 32 + d * 16 + hi * 8), c1 = *(const GAS f32x4*)(U.COS + (size_t)pos * 32 + d * 16 + hi * 8 + 4);
              const f32x4 s0 = *(const GAS f32x4*)(U.SIN + (size_t)pos * 32 + d * 16 + hi * 8), s1 = *(const GAS f32x4*)(U.SIN + (size_t)pos * 32 + d * 16 + hi * 8 + 4);
              float n1[8], n2[8];
#pragma unroll
              for (int j = 0; j < 8; ++j) { const float t1 = bf2f((unsigned short)f[d][j]), t2 = bf2f((unsigned short)f[d + 2][j]); const float c = j < 4 ? c0[j & 3] : c1[j & 3], s = j < 4 ? s0[j & 3] : s1[j & 3];
                  n1[j] = t1 * c - t2 * s; n2[j] = t1 * s + t2 * c; }
              u32x4 w1 = {pk2(n1[0], n1[1]), pk2(n1[2], n1[3]), pk2(n1[4], n1[5]), pk2(n1[6], n1[7])}, w2 = {pk2(n2[0], n2[1]), pk2(n2[2], n2[3]), pk2(n2[4], n2[5]), pk2(n2[6], n2[7])};
              qr[8 + d] = __builtin_bit_cast(bf16x8, w1); qr[10 + d] = __builtin_bit_cast(bf16x8, w2);
          }
      }
    }
    float qb2 = 0.f;
    if constexpr (VAR == 3) { float sq = 0.f;
#pragma unroll
        for (int d0 = 0; d0 < 8; ++d0)
#pragma unroll
            for (int j = 0; j < 8; ++j) { const float v = bf2f((unsigned short)qr[d0][j]); sq += v * v; }
        sq = xsum(sq); qb2 = sqrtf(sq * U.kn2) * C2; }
    unsigned dk, dv, dkr = 0;
    { const int krow = 4 * wid + (lane >> 4); dk = (unsigned)(krow * U.kp + (((lane & 15) ^ (krow & 7)) * 8)) * 2u;
      const int kk = ((wid >> 1) << 3) | ((lane & 31) >> 2); const int kv = (kk & ~0xC) | ((kk & 4) << 1) | ((kk & 8) >> 1); const int cv = (2 * (wid & 1) + (lane >> 5)) * 32 + (lane & 3) * 8;
      dv = (unsigned)(kv * U.vp + cv) * 2u;
      if constexpr (VAR == 0) { const int rr = 8 * wid + (lane >> 3); dkr = (unsigned)(rr * 64 + (((lane & 7) ^ (rr & 7)) * 8)) * 2u; } }
    float st_b = 0.f;
    float cref = 0.f; if constexpr (VAR == 3) cref = U.CK[P0];
#define FA_SLOAD(kb, bf) do { const char* kb_ = (const char*)(U.K + (size_t)(kb) * U.kp); const char* vb_ = (const char*)(U.V + (size_t)(kb) * U.vp); \
        __builtin_amdgcn_global_load_lds((const unsigned*)(kb_ + dk), FA_LP(unsigned, L_K + (bf) * SHM + wid * 1024), 16, 0, 0); \
        __builtin_amdgcn_global_load_lds((const unsigned*)(kb_ + (size_t)64 * U.kp + dk), FA_LP(unsigned, L_K + (bf) * SHM + 8192 + wid * 1024), 16, 0, 0); \
        __builtin_amdgcn_global_load_lds((const unsigned*)(vb_ + dv), FA_LP(unsigned, L_V + (bf) * SHM + wid * 1024), 16, 0, 0); \
        __builtin_amdgcn_global_load_lds((const unsigned*)(vb_ + (size_t)64 * U.vp + dv), FA_LP(unsigned, L_V + (bf) * SHM + 8192 + wid * 1024), 16, 0, 0); \
        if constexpr (VAR == 0) __builtin_amdgcn_global_load_lds((const unsigned*)((const char*)(U.KR + (size_t)(kb) * 64) + dkr), FA_LP(unsigned, L_KR + (bf) * 8192 + wid * 1024), 16, 0, 0); \
        if constexpr (VAR == 3) { st_b = U.CK[(kb) + lane]; } } while (0)
#define FA_SWRITE(bf) do { \
        if constexpr (VAR == 3) { if (tid < 64) *FA_LP(float, L_BIAS + (bf) * 256 + tid * 4) = (cref - st_b) * 1.4426950408889634f; } } while (0)
    LAS float* li_l = FA_LP(float, L_WS + wid * 256); LAS float* al_l = li_l + 32;
    const unsigned vb0 = (unsigned)(uintptr_t)(lds + L_V) + v_rd_base(lane);
    unsigned kb4[4];
#pragma unroll
    for (int dd = 0; dd < 4; ++dd) kb4[dd] = (unsigned)(uintptr_t)(lds + L_K) + kswz(r32, (dd * 16 + hi * 8) * 2);
    unsigned krb4[4];
    if constexpr (VAR == 0) {
#pragma unroll
        for (int dd = 0; dd < 4; ++dd) krb4[dd] = (unsigned)(uintptr_t)(lds + L_KR) + krswz(r32, (dd * 16 + hi * 8) * 2);
    }
    float m2 = -1e30f, l_reg = 0.f, R2 = 0.f;
    f32x16 o[4];
#pragma unroll
    for (int d = 0; d < 4; ++d)
#pragma unroll
        for (int r = 0; r < 16; ++r) o[d][r] = 0.f;
    bool wdone = false;
    FA_SLOAD((j_hi - 1) * 64, 0);
    asm volatile("s_waitcnt vmcnt(0)" ::: "memory");
    FA_SWRITE(0);
    __syncthreads();

#define FA_TRRD(dst, off) asm volatile("ds_read_b64_tr_b16 %0, %1 offset:%2" : "=&v"(dst) : "v"(vb0), "i"(off) : "memory")
#define FA_VRD8(S, BUF, d0) do { constexpr int b_ = (BUF) * SHM + v_rd_off(d0, 0, 0); \
        FA_TRRD(S##l0, b_); FA_TRRD(S##h0, b_ + 2048); FA_TRRD(S##l1, b_ + 4096); FA_TRRD(S##h1, b_ + 6144); FA_TRRD(S##l2, b_ + 8192); FA_TRRD(S##h2, b_ + 10240); FA_TRRD(S##l3, b_ + 12288); FA_TRRD(S##h3, b_ + 14336); } while (0)
#define FA_PVMMA(S, d0) do { \
        o[d0] = __builtin_amdgcn_mfma_f32_32x32x16_bf16(pa0, (bf16x8){S##l0[0], S##l0[1], S##l0[2], S##l0[3], S##h0[0], S##h0[1], S##h0[2], S##h0[3]}, o[d0], 0, 0, 0); \
        o[d0] = __builtin_amdgcn_mfma_f32_32x32x16_bf16(pa1, (bf16x8){S##l1[0], S##l1[1], S##l1[2], S##l1[3], S##h1[0], S##h1[1], S##h1[2], S##h1[3]}, o[d0], 0, 0, 0); \
        o[d0] = __builtin_amdgcn_mfma_f32_32x32x16_bf16(pa2, (bf16x8){S##l2[0], S##l2[1], S##l2[2], S##l2[3], S##h2[0], S##h2[1], S##h2[2], S##h2[3]}, o[d0], 0, 0, 0); \
        o[d0] = __builtin_amdgcn_mfma_f32_32x32x16_bf16(pa3, (bf16x8){S##l3[0], S##l3[1], S##l3[2], S##l3[3], S##h3[0], S##h3[1], S##h3[2], S##h3[3]}, o[d0], 0, 0, 0); } while (0)
#define FA_LGKM(n) asm volatile("s_waitcnt lgkmcnt(" #n ")" ::: "memory")
#define FA_PV(BUF) do { s16x4 Xl0, Xl1, Xl2, Xl3, Xh0, Xh1, Xh2, Xh3, Yl0, Yl1, Yl2, Yl3, Yh0, Yh1, Yh2, Yh3; \
        FA_VRD8(X, BUF, 0); FA_VRD8(Y, BUF, 1); FA_LGKM(8); FA_SBAR(); FA_PVMMA(X, 0); FA_SBAR(); \
        FA_VRD8(X, BUF, 2); FA_LGKM(8); FA_SBAR(); FA_PVMMA(Y, 1); FA_SBAR(); \
        FA_VRD8(Y, BUF, 3); FA_LGKM(8); FA_SBAR(); FA_PVMMA(X, 2); FA_SBAR(); \
        FA_LGKM(0); FA_SBAR(); FA_PVMMA(Y, 3); } while (0)
#define FA_KRD(dst, areg, off) asm volatile("ds_read_b128 %0, %1 offset:%2" : "=&v"(dst) : "v"(areg), "i"(off) : "memory")
#define FA_KPAIR(A_, B_, BUF, d0) do { if constexpr ((d0) < 8) { FA_KRD(A_, kb4[(d0) & 3], ((d0) >> 2) * 128 + (BUF) * SHM); FA_KRD(B_, kb4[(d0) & 3], ((d0) >> 2) * 128 + (BUF) * SHM + 32 * 256); } \
        else { FA_KRD(A_, krb4[((d0) - 8) & 3], (BUF) * 8192); FA_KRD(B_, krb4[((d0) - 8) & 3], (BUF) * 8192 + 32 * 128); } } while (0)
#define FA_QKMMA(A_, B_, d0) do { p0 = __builtin_amdgcn_mfma_f32_32x32x16_bf16(A_, qr[d0], p0, 0, 0, 0); p1 = __builtin_amdgcn_mfma_f32_32x32x16_bf16(B_, qr[d0], p1, 0, 0, 0); } while (0)
#define FA_QKSTEP(CA, CB, NA, NB, BUF, d0) do { if constexpr ((d0) + 1 < NQ) { FA_KPAIR(NA, NB, BUF, (d0) + 1); FA_LGKM(2); } else { FA_LGKM(0); } FA_SBAR(); FA_QKMMA(CA, CB, d0); FA_SBAR(); } while (0)
#define FA_QK(BUF) do { bf16x8 ea, eb, fa_, fb; FA_KPAIR(ea, eb, BUF, 0); \
        FA_QKSTEP(ea, eb, fa_, fb, BUF, 0); FA_QKSTEP(fa_, fb, ea, eb, BUF, 1); FA_QKSTEP(ea, eb, fa_, fb, BUF, 2); FA_QKSTEP(fa_, fb, ea, eb, BUF, 3); \
        FA_QKSTEP(ea, eb, fa_, fb, BUF, 4); FA_QKSTEP(fa_, fb, ea, eb, BUF, 5); FA_QKSTEP(ea, eb, fa_, fb, BUF, 6); FA_QKSTEP(fa_, fb, ea, eb, BUF, 7); \
        if constexpr (NQ == 12) { FA_QKSTEP(ea, eb, fa_, fb, BUF, 8); FA_QKSTEP(fa_, fb, ea, eb, BUF, 9); FA_QKSTEP(ea, eb, fa_, fb, BUF, 10); FA_QKSTEP(fa_, fb, ea, eb, BUF, 11); } } while (0)
#define FA_PK4(P, B_, OUT) do { unsigned a0 = cvtpk(P[B_ + 0], P[B_ + 1]), a1 = cvtpk(P[B_ + 2], P[B_ + 3]); unsigned b0 = cvtpk(P[B_ + 4], P[B_ + 5]), b1 = cvtpk(P[B_ + 6], P[B_ + 7]); \
        auto r0 = __builtin_amdgcn_permlane32_swap(a0, b0, false, false); auto r1 = __builtin_amdgcn_permlane32_swap(a1, b1, false, false); \
        u32x4 w = {r0[0], r1[0], r0[1], r1[1]}; OUT = __builtin_bit_cast(bf16x8, w); } while (0)

#define FA_STEP(BUF, jt) do { \
        const int kb = (jt) * 64; const bool more = (jt) > j_lo; \
        if (more) FA_SLOAD(kb - 64, (BUF) ^ 1); \
        const bool act = !wdone && (kb <= qlo + 31) && (kb + 63 >= qlo - W + 1); \
        if (act) { \
            f32x16 p0, p1; \
            _Pragma("unroll") for (int r = 0; r < 16; ++r) { p0[r] = 0.f; p1[r] = 0.f; } \
            FA_QK(BUF); \
            bf16x8 pa0, pa1, pa2, pa3; \
            const int dq = qm - kb; \
            const bool needmask = (kb + 63 >= qlo) || (kb <= qlo + 31 - W); \
            if constexpr (VAR == 2) { \
                  \
                _Pragma("unroll") for (int r = 0; r < 16; ++r) { p0[r] = fminf(p0[r] * C2, 100.f); p1[r] = fminf(p1[r] * C2, 100.f); } \
                f32x16 x0, x1; \
                _Pragma("unroll") for (int r = 0; r < 16; ++r) { x0[r] = __builtin_amdgcn_logf(1.f + __builtin_amdgcn_exp2f(p0[r])); x1[r] = __builtin_amdgcn_logf(1.f + __builtin_amdgcn_exp2f(p1[r])); } \
                if (needmask) { _Pragma("unroll") for (int r = 0; r < 16; ++r) { const int c = (r & 3) + 8 * (r >> 2); \
                    if (dq - c < 0) { x0[r] = 0.f; p0[r] = -__builtin_inff(); } if (dq - c - 32 < 0) { x1[r] = 0.f; p1[r] = -__builtin_inff(); } } } \
                float S0[4], S1[4], C0[4], C1[4]; \
                _Pragma("unroll") for (int i = 0; i < 4; ++i) { S0[i] = (x0[4 * i] + x0[4 * i + 1]) + (x0[4 * i + 2] + x0[4 * i + 3]); S1[i] = (x1[4 * i] + x1[4 * i + 1]) + (x1[4 * i + 2] + x1[4 * i + 3]); \
                    C0[i] = xsum(S0[i]); C1[i] = xsum(S1[i]); } \
                const float fsel = hi ? 0.f : 1.f; \
                float E1[4], E0[4]; E1[3] = 0.f; E1[2] = C1[3]; E1[1] = E1[2] + C1[2]; E1[0] = E1[1] + C1[1]; const float T1 = E1[0] + C1[0]; \
                E0[3] = 0.f; E0[2] = C0[3]; E0[1] = E0[2] + C0[2]; E0[0] = E0[1] + C0[1]; const float T0 = E0[0] + C0[0]; \
                _Pragma("unroll") for (int i = 0; i < 4; ++i) { \
                    float ag = R2 + E1[i] + fsel * (C1[i] - S1[i]); \
                    float a3 = ag, a2 = a3 + x1[4 * i + 3], a1 = a2 + x1[4 * i + 2], a0 = a1 + x1[4 * i + 1]; \
                    p1[4 * i + 3] = __builtin_amdgcn_exp2f(p1[4 * i + 3] - x1[4 * i + 3] - a3); p1[4 * i + 2] = __builtin_amdgcn_exp2f(p1[4 * i + 2] - x1[4 * i + 2] - a2); \
                    p1[4 * i + 1] = __builtin_amdgcn_exp2f(p1[4 * i + 1] - x1[4 * i + 1] - a1); p1[4 * i + 0] = __builtin_amdgcn_exp2f(p1[4 * i + 0] - x1[4 * i + 0] - a0); \
                    ag = R2 + T1 + E0[i] + fsel * (C0[i] - S0[i]); \
                    a3 = ag; a2 = a3 + x0[4 * i + 3]; a1 = a2 + x0[4 * i + 2]; a0 = a1 + x0[4 * i + 1]; \
                    p0[4 * i + 3] = __builtin_amdgcn_exp2f(p0[4 * i + 3] - x0[4 * i + 3] - a3); p0[4 * i + 2] = __builtin_amdgcn_exp2f(p0[4 * i + 2] - x0[4 * i + 2] - a2); \
                    p0[4 * i + 1] = __builtin_amdgcn_exp2f(p0[4 * i + 1] - x0[4 * i + 1] - a1); p0[4 * i + 0] = __builtin_amdgcn_exp2f(p0[4 * i + 0] - x0[4 * i + 0] - a0); } \
                R2 += T0 + T1; \
                FA_PK4(p0, 0, pa0); FA_PK4(p0, 8, pa1); FA_PK4(p1, 0, pa2); FA_PK4(p1, 8, pa3); \
            } else { \
                if constexpr (VAR == 3) { \
                    _Pragma("unroll") for (int g = 0; g < 4; ++g) { const f32x4 b0 = *FA_LP(f32x4, L_BIAS + (BUF) * 256 + (8 * g + 4 * hi) * 4), b1 = *FA_LP(f32x4, L_BIAS + (BUF) * 256 + (32 + 8 * g + 4 * hi) * 4); \
                        _Pragma("unroll") for (int e = 0; e < 4; ++e) { p0[4 * g + e] = fmaf(p0[4 * g + e], C2, b0[e]); p1[4 * g + e] = fmaf(p1[4 * g + e], C2, b1[e]); } } \
                } \
                if (needmask) { _Pragma("unroll") for (int r = 0; r < 16; ++r) { const int c = (r & 3) + 8 * (r >> 2); \
                    if ((unsigned)(dq - c) >= (unsigned)W) p0[r] = -__builtin_inff(); if ((unsigned)(dq - c - 32) >= (unsigned)W) p1[r] = -__builtin_inff(); } } \
                float pmax = p0[0]; \
                _Pragma("unroll") for (int r = 1; r < 16; ++r) pmax = fmaxf(pmax, p0[r]); \
                _Pragma("unroll") for (int r = 0; r < 16; ++r) pmax = fmaxf(pmax, p1[r]); \
                pmax = xmax(pmax); if constexpr (VAR != 3) pmax *= C2;     \
                float alpha = 1.f; \
                if (!__all(pmax - m2 <= THR2)) { const float mn = fmaxf(m2, pmax); alpha = __builtin_amdgcn_exp2f(m2 - mn); m2 = mn; } \
                float ps = 0.f; \
                if constexpr (VAR == 3) { _Pragma("unroll") for (int r = 0; r < 16; ++r) { p0[r] = __builtin_amdgcn_exp2f(p0[r] - m2); p1[r] = __builtin_amdgcn_exp2f(p1[r] - m2); ps += p0[r] + p1[r]; } } \
                else { const float nm2 = -m2; _Pragma("unroll") for (int r = 0; r < 16; ++r) { p0[r] = __builtin_amdgcn_exp2f(fmaf(p0[r], C2, nm2)); p1[r] = __builtin_amdgcn_exp2f(fmaf(p1[r], C2, nm2)); ps += p0[r] + p1[r]; } } \
                ps = xsum(ps); l_reg = l_reg * alpha + ps; \
                if (__any(alpha < 1.f)) { if (hi == 0) al_l[r32] = alpha; asm volatile("s_waitcnt lgkmcnt(0)" ::: "memory"); \
                    _Pragma("unroll") for (int r = 0; r < 16; ++r) { const float a_ = al_l[crow(r, hi)]; o[0][r] *= a_; o[1][r] *= a_; o[2][r] *= a_; o[3][r] *= a_; } } \
                FA_PK4(p0, 0, pa0); FA_PK4(p0, 8, pa1); FA_PK4(p1, 0, pa2); FA_PK4(p1, 8, pa3); \
            } \
            FA_SBAR(); FA_PV(BUF); \
        } \
        if (more) { asm volatile("s_waitcnt vmcnt(0)" ::: "memory"); FA_SWRITE((BUF) ^ 1); } \
        if constexpr (VAR == 2) wdone = wdone || __all(R2 > 64.f); \
        if constexpr (VAR == 3) { if (more) { const float bnext = (cref - __builtin_bit_cast(float, __builtin_amdgcn_readlane(__builtin_bit_cast(int, st_b), 63))) * 1.4426950408889634f; wdone = wdone || __all(qb2 + bnext - m2 < -40.f); } } \
        if constexpr (VAR == 2 || VAR == 3) { if (lane == 0) *FA_LP(int, L_FLAG + (BUF) * 32 + wid * 4) = wdone ? 1 : 0; } \
        asm volatile("s_waitcnt lgkmcnt(0)" ::: "memory"); __builtin_amdgcn_s_barrier(); asm volatile("" ::: "memory");     \
        if constexpr (VAR == 2 || VAR == 3) { int nd = 0; _Pragma("unroll") for (int w_ = 0; w_ < 8; ++w_) nd += *FA_LP(int, L_FLAG + (BUF) * 32 + w_ * 4); if (nd == 8) goto fa_done; } \
    } while (0)

    for (int jt = j_hi - 1; jt >= j_lo; jt -= 2) {
        FA_STEP(0, jt);
        if (jt - 1 < j_lo) break;
        FA_STEP(1, jt - 1);
    }
fa_done:
    {
        const int tid2 = opaque(tid); const int r32 = tid2 & 31, hi = (tid2 >> 5) & 1;
        float rli[16];
        if constexpr (VAR != 2) {
            if (hi == 0) li_l[r32] = l_reg; asm volatile("s_waitcnt lgkmcnt(0)" ::: "memory");
#pragma unroll
            for (int r = 0; r < 16; ++r) rli[r] = __builtin_amdgcn_rcpf(li_l[crow(r, hi)]);
        } else {
#pragma unroll
            for (int r = 0; r < 16; ++r) rli[r] = 1.f;
        }
        bf16* Ow = U.O + (size_t)(wid * 32) * U.op;
        { const bool odd = (r32 & 1) != 0, up2 = (r32 & 2) != 0;
#define FA_X1(x) __builtin_bit_cast(float, __builtin_amdgcn_mov_dpp(__builtin_bit_cast(int, (x)), 0xB1, 0xF, 0xF, true))
#define FA_X2(x) ((unsigned)__builtin_amdgcn_mov_dpp((int)(x), 0x4E, 0xF, 0xF, true))
#pragma unroll
          for (int rg = 0; rg < 4; ++rg) { const int r0 = 4 * rg; bf16* rowp = Ow + (size_t)(8 * rg + 4 * hi + (r32 & 3)) * U.op + (r32 & ~3);
#pragma unroll
            for (int d0 = 0; d0 < 4; ++d0) {
                const float v0 = o[d0][r0] * rli[r0], v1 = o[d0][r0 + 1] * rli[r0 + 1], v2 = o[d0][r0 + 2] * rli[r0 + 2], v3 = o[d0][r0 + 3] * rli[r0 + 3];
                const float n0 = FA_X1(v0), n1 = FA_X1(v1), n2 = FA_X1(v2), n3 = FA_X1(v3);
                const unsigned wa = cvtpk(odd ? n1 : v0, odd ? v1 : n0), wb = cvtpk(odd ? n3 : v2, odd ? v3 : n2);
                const unsigned got = FA_X2(up2 ? wa : wb);
                const unsigned long long w8 = up2 ? ((unsigned long long)got | ((unsigned long long)wb << 32)) : ((unsigned long long)wa | ((unsigned long long)got << 32));
                *(GAS unsigned long long*)(rowp + d0 * 32) = w8; } }
#undef FA_X1
#undef FA_X2
        }
        if constexpr (VAR != 2) { if (U.LSE != nullptr && hi == 0) U.LSE[(size_t)(wid * 32 + r32) * U.lp] = (m2 + __builtin_amdgcn_logf(l_reg)) * 0.6931471805599453f; }
    }
    __syncthreads();
#undef FA_SLOAD
#undef FA_SWRITE
#undef FA_TRRD
#undef FA_VRD8
#undef FA_PVMMA
#undef FA_LGKM
#undef FA_PV
#undef FA_KRD
#undef FA_KPAIR
#undef FA_QKMMA
#undef FA_QKSTEP
#undef FA_QK
#undef FA_PK4
#undef FA_STEP
}
}


#ifndef FASTMASK
#define FASTMASK 15
#endif
__device__ __forceinline__ void fast_attn_phase(Frame& F, const Ptrs& P, int l, int vmask = 15) {
    LAS unsigned char* lds = F.lds + RING_OFF;
    LAS int* itemw = (LAS int*)(lds + fa::L_ITEM);
    gu32* qhead = F.ctl + CW_QUEUE + 64 * l;
    bf16* PROJ = wsb(P, WS_PROJ); bf16* O = wsb(P, WS_O);
    constexpr int N_A = 384, N_D = 256, N_C = 256, N_B = 768, N_REST = N_D + N_C + N_B;
    constexpr int CV_IN = (DM / 64) * (NP / 64) + (QLR / 64) * (NQA / 64) + 2 * (KVLR / 64) * (GW / 64), CV_GRP = (DM / 64) * (DM / 64) + (DM / 64) * (DFF / 64) + (DFF / 64) * (DM / 64), CH = 64;
    constexpr int NC_GRP = (CV_GRP + CH - 1) / CH, NC_IN = (CV_IN + CH - 1) / CH;
    const int n_conv = (vmask == 15) ? NC_GRP + ((l == 0) ? NC_IN : 0) : 0;
    const int n_pair = (n_conv < N_A + N_REST) ? n_conv : N_A + N_REST;
    const int N_ITEMS = N_A + N_REST + n_conv;
    for (;;) {
        if (F.tid == 0) *itemw = (int)__hip_atomic_fetch_add(qhead, 1u, __ATOMIC_RELAXED, __HIP_MEMORY_SCOPE_AGENT);
        __syncthreads();
        int item = __builtin_amdgcn_readfirstlane(*itemw);
        __syncthreads();
        if (item >= N_ITEMS) break;
        {
            const int j = item; int cv = -1, un;
            if (j < 2 * n_pair) { if (j & 1) cv = j >> 1; else un = j >> 1; } else { const int t = j - 2 * n_pair; if (n_conv > N_A + N_REST) cv = n_pair + t; else un = n_pair + t; }
            if (cv >= 0) {
                if (cv < NC_GRP) { const int lo_ = CV_IN + cv * CH; conv_range(F, P, l, lo_, (lo_ + CH < CV_IN + CV_GRP) ? lo_ + CH : CV_IN + CV_GRP); }
                else { const int lo_ = (cv - NC_GRP) * CH; conv_range(F, P, 1, lo_, (lo_ + CH < CV_IN) ? lo_ + CH : CV_IN); }
                continue; }
            item = un;
        }
        fa::UnitRef U; U.KR = nullptr; U.CK = nullptr; U.COS = nullptr; U.SIN = nullptr; U.LSE = nullptr; U.lp = 0; U.kn2 = 0.f;
        if (item < N_A) {
            if (!(FASTMASK & 1) || !(vmask & 1)) continue;
            const int a = item >> 3, h = item & 7, k = a / 3, j = a - 3 * k;
            const int qb = (j < 2) ? 31 - k : 15 - k;
            U.Q = wsb(P, WS_QA) + (size_t)(qb * 256) * NQA + h * 192; U.qp = NQA; U.K = wsb(P, WS_KVU) + h * HD; U.kp = NKVU; U.V = wsb(P, WS_KVU) + GW + h * HD; U.vp = NKVU;
            U.KR = wsb(P, WS_KR); U.COS = wsf(P, WS_COS64); U.SIN = wsf(P, WS_SIN64); U.P0 = qb * 256;
            if (j < 2) { U.jlo = j * 2 * (qb + 1); U.jhi = (j + 1) * 2 * (qb + 1);
                U.O = wsb(P, WS_PA) + (size_t)j * S * GW + (size_t)(qb * 256) * GW + h * HD; U.op = GW; U.LSE = wsf(P, WS_LSEA) + (size_t)j * S * NH + (size_t)(qb * 256) * NH + h; U.lp = NH; }
            else { U.jlo = 0; U.jhi = 4 * (qb + 1); U.O = O + (size_t)(qb * 256) * DM + h * HD; U.op = DM; }
            fa::attn_unit<0>(lds, U, opaque(F.tid));
        } else if (item < N_A + N_D) {
            if (!(FASTMASK & 8) || !(vmask & 8)) continue;
            const int i = item - N_A, qb = 31 - (i >> 3), h = i & 7;
            U.Q = PROJ + (size_t)(qb * 256) * NP + PC_D + h * HD; U.qp = NP; U.K = PROJ + PC_D + GW + h * HD; U.kp = NP; U.V = PROJ + PC_D + 2 * GW + h * HD; U.vp = NP;
            U.CK = wsf(P, WS_CK) + (size_t)h * S; U.O = O + (size_t)(qb * 256) * DM + 3 * GW + h * HD; U.op = DM; U.P0 = qb * 256; U.jlo = 0; U.jhi = 4 * (qb + 1);
            U.kn2 = __builtin_bit_cast(float, __hip_atomic_load(F.ctl + CW_KN + 16 * (l & 1) + h, __ATOMIC_RELAXED, __HIP_MEMORY_SCOPE_AGENT));
            fa::attn_unit<3>(lds, U, opaque(F.tid));
        } else if (item < N_A + N_D + N_C) {
            if (!(FASTMASK & 4) || !(vmask & 4)) continue;
            const int i = item - N_A - N_D, qb = 31 - (i >> 3), h = i & 7;
            U.Q = PROJ + (size_t)(qb * 256) * NP + PC_C + h * HD; U.qp = NP; U.K = PROJ + PC_C + GW + h * HD; U.kp = NP; U.V = PROJ + PC_C + 2 * GW + h * HD; U.vp = NP;
            U.O = O + (size_t)(qb * 256) * DM + 2 * GW + h * HD; U.op = DM; U.P0 = qb * 256; U.jlo = 0; U.jhi = 4 * (qb + 1);
            fa::attn_unit<2>(lds, U, opaque(F.tid));
        } else {
            if (!(FASTMASK & 2) || !(vmask & 2)) continue;
            const int i = item - N_A - N_D - N_C, br = i >> 8, rest = i & 255, h = rest & 7, blk = rest >> 3;
            const int dil = (br == 0) ? 1 : (br == 1) ? 4 : 16; const int nbr = (S / dil) / 256; const int res = blk / nbr, bi = blk - res * nbr;
            const size_t tok0 = (size_t)res + (size_t)dil * (bi * 256);
            U.Q = PROJ + tok0 * NP + PC_B + h * HD; U.qp = dil * NP; U.K = PROJ + (size_t)res * NP + PC_B + GW + h * HD; U.kp = dil * NP; U.V = PROJ + (size_t)res * NP + PC_B + 2 * GW + h * HD; U.vp = dil * NP;
            U.O = wsb(P, WS_OB) + (size_t)br * S * GW + tok0 * GW + h * HD; U.op = dil * GW; U.LSE = wsf(P, WS_LSE) + (size_t)br * S * NH + tok0 * NH + h; U.lp = dil * NH; U.P0 = bi * 256;
            U.jlo = (bi * 256 - 128 > 0) ? (bi * 256 - 128) / 64 : 0; U.jhi = 4 * (bi + 1);
            fa::attn_unit<1>(lds, U, opaque(F.tid));
        }
    }
}

__device__ __forceinline__ void slow_attn_task(const Ptrs& P, int var, int h, int t, int lane) {
    const bf16* PROJ = wsb(P, WS_PROJ); bf16* O = wsb(P, WS_O);
    const bf16 *qp, *kbase, *vbase; int kp;
    float scale = 0.08838834764831845f;
    float qr_ = 0.f;
    const bf16* krb = wsb(P, WS_KR);
    if (var == 0) { qp = wsb(P, WS_QA) + (size_t)t * NQA + h * 192; kbase = wsb(P, WS_KVU) + h * HD; vbase = wsb(P, WS_KVU) + GW + h * HD; kp = NKVU; scale = 0.07216878364870323f;
        const float mine = bf2f(qp[128 + lane]); const float other = __shfl_xor(mine, 32);
        const float c = wsf(P, WS_COS64)[t * 32 + (lane & 31)], sn = wsf(P, WS_SIN64)[t * 32 + (lane & 31)];
        qr_ = (lane < 32) ? (mine * c - other * sn) : (other * sn + mine * c);
        qr_ = bf2f((bf16)f2bf(qr_)); }
    else { const int pc = (var == 1) ? PC_B : (var == 2) ? PC_C : PC_D; qp = PROJ + (size_t)t * NP + pc + h * HD; kbase = PROJ + pc + GW + h * HD; vbase = PROJ + pc + 2 * GW + h * HD; kp = NP; }
    const unsigned qw = *(const GAS unsigned*)(qp + 2 * lane); const float q0 = bflo(qw), q1 = bfhi(qw);
    float o0 = 0.f, o1 = 0.f;
    if (var == 2) {
        float R = 0.f;
        for (int s0 = t - 1; s0 >= 0; s0 -= 4) {
            float part[4]; unsigned vw[4];
#pragma unroll
            for (int i = 0; i < 4; ++i) { const int s = s0 - i; const int sc = s < 0 ? 0 : s; const unsigned kw = *(const GAS unsigned*)(kbase + (size_t)sc * kp + 2 * lane); vw[i] = *(const GAS unsigned*)(vbase + (size_t)sc * kp + 2 * lane);
                part[i] = q0 * bflo(kw) + q1 * bfhi(kw); }
#pragma unroll
            for (int i = 0; i < 4; ++i) part[i] = wave_sum(part[i]);
#pragma unroll
            for (int i = 0; i < 4; ++i) { if (s0 - i >= 0) { const float z = part[i] * scale; const float sp = fmaxf(z, 0.f) + log1pf(expf(-fabsf(z))); const float a = expf(z - sp - R); R += sp; o0 += a * bflo(vw[i]); o1 += a * bfhi(vw[i]); } }
            if (R > 100.f) break;
        }
    } else {
        float m = -1e30f, lsum = 0.f;
        const float* CK = wsf(P, WS_CK) + (size_t)h * S; const float cq = (var == 3) ? CK[t] : 0.f;
        const int nbr = (var == 1) ? 3 : 1;
        for (int br = 0; br < nbr; ++br) {
            const int dil = (var == 1) ? (br == 0 ? 1 : br == 1 ? 4 : 16) : 1; const int nk = (var == 1) ? 129 : t + 1;
            for (int j0 = 0; j0 < nk; j0 += 4) {
                float part[4]; unsigned vw[4]; float bias[4]; bool ok[4];
#pragma unroll
                for (int i = 0; i < 4; ++i) { const int j = j0 + i; const int s = t - dil * j; ok[i] = (j < nk) && (s >= 0); const int sc = ok[i] ? s : 0;
                    const unsigned kw = *(const GAS unsigned*)(kbase + (size_t)sc * kp + 2 * lane); vw[i] = *(const GAS unsigned*)(vbase + (size_t)sc * kp + 2 * lane);
                    part[i] = q0 * bflo(kw) + q1 * bfhi(kw);
                    if (var == 0) part[i] += qr_ * bf2f(krb[(size_t)sc * 64 + lane]);
                    bias[i] = (var == 3) ? (cq - CK[sc]) : 0.f; }
#pragma unroll
                for (int i = 0; i < 4; ++i) part[i] = wave_sum(part[i]);
                float sc4[4]; float mx = m;
#pragma unroll
                for (int i = 0; i < 4; ++i) { sc4[i] = ok[i] ? part[i] * scale + bias[i] : -__builtin_inff(); mx = fmaxf(mx, sc4[i]); }
                const float alpha = expf(m - mx); lsum *= alpha; o0 *= alpha; o1 *= alpha; m = mx;
#pragma unroll
                for (int i = 0; i < 4; ++i) { const float p = expf(sc4[i] - mx); lsum += p; o0 += p * bflo(vw[i]); o1 += p * bfhi(vw[i]); }
            }
        }
        o0 /= lsum; o1 /= lsum;
    }
    *(GAS unsigned*)(O + (size_t)t * DM + var * GW + h * HD + 2 * lane) = pk2(o0, o1);
}
__device__ __forceinline__ void slow_attn_phase(Frame& F, const Ptrs& P) {
    const int gw = blockIdx.x * NWAVES + F.wave, NGW = F.G * NWAVES;
    for (int k = 0; (size_t)k * NGW + gw < (size_t)S * 32; ++k) {
        const int n = k * NGW + gw; const int t = n >> 5; const int hv = (gw + k) & 31;
        if ((FASTMASK >> (hv & 3)) & 1) continue;
        slow_attn_task(P, hv & 3, hv >> 2, t, F.lane);
    }
}

__device__ __forceinline__ void groupnorm_rows(Frame& F, const Ptrs& P, int l) {
    const int gw = blockIdx.x * NWAVES + F.wave, NGW = F.G * NWAVES, lane = F.lane;
    const bf16* O = wsb(P, WS_O); bf16* ON = wsb(P, WS_H); const float* go = P.g_out + (size_t)l * DM;
    for (int m = gw; m < S; m += NGW) {
#pragma unroll
        for (int g = 0; g < 4; ++g) {
            float f[16]; float s = 0.f;
#pragma unroll
            for (int c = 0; c < 2; ++c) {
                if ((FASTMASK & 2) && g == 1) {
                    const int hh = c * 4 + (lane >> 4); const float* L = wsf(P, WS_LSE) + (size_t)m * NH + hh;
                    const float l0 = L[0], l1 = L[(size_t)S * NH], l2 = L[(size_t)2 * S * NH]; const float mx = fmaxf(l0, fmaxf(l1, l2));
                    float w0 = expf(l0 - mx), w1 = expf(l1 - mx), w2 = expf(l2 - mx); const float inv = 1.f / (w0 + w1 + w2); w0 *= inv; w1 *= inv; w2 *= inv;
                    const bf16* ob = wsb(P, WS_OB) + (size_t)m * GW + c * 512 + 8 * lane;
                    const v4u a = *(const GAS v4u*)ob, b = *(const GAS v4u*)(ob + (size_t)S * GW), d = *(const GAS v4u*)(ob + (size_t)2 * S * GW);
                    f[8 * c + 0] = w0 * bflo(a.x) + w1 * bflo(b.x) + w2 * bflo(d.x); f[8 * c + 1] = w0 * bfhi(a.x) + w1 * bfhi(b.x) + w2 * bfhi(d.x);
                    f[8 * c + 2] = w0 * bflo(a.y) + w1 * bflo(b.y) + w2 * bflo(d.y); f[8 * c + 3] = w0 * bfhi(a.y) + w1 * bfhi(b.y) + w2 * bfhi(d.y);
                    f[8 * c + 4] = w0 * bflo(a.z) + w1 * bflo(b.z) + w2 * bflo(d.z); f[8 * c + 5] = w0 * bfhi(a.z) + w1 * bfhi(b.z) + w2 * bfhi(d.z);
                    f[8 * c + 6] = w0 * bflo(a.w) + w1 * bflo(b.w) + w2 * bflo(d.w); f[8 * c + 7] = w0 * bfhi(a.w) + w1 * bfhi(b.w) + w2 * bfhi(d.w);
                    continue; }
                if ((FASTMASK & 1) && g == 0 && m >= S / 2) {
                    const int hh = c * 4 + (lane >> 4); const float* L = wsf(P, WS_LSEA) + (size_t)m * NH + hh;
                    const float l0 = L[0], l1 = L[(size_t)S * NH]; const float mx = fmaxf(l0, l1);
                    float w0 = expf(l0 - mx), w1 = expf(l1 - mx); const float inv = 1.f / (w0 + w1); w0 *= inv; w1 *= inv;
                    const bf16* ob = wsb(P, WS_PA) + (size_t)m * GW + c * 512 + 8 * lane;
                    const v4u a = *(const GAS v4u*)ob, b = *(const GAS v4u*)(ob + (size_t)S * GW);
                    f[8 * c + 0] = w0 * bflo(a.x) + w1 * bflo(b.x); f[8 * c + 1] = w0 * bfhi(a.x) + w1 * bfhi(b.x); f[8 * c + 2] = w0 * bflo(a.y) + w1 * bflo(b.y); f[8 * c + 3] = w0 * bfhi(a.y) + w1 * bfhi(b.y);
                    f[8 * c + 4] = w0 * bflo(a.z) + w1 * bflo(b.z); f[8 * c + 5] = w0 * bfhi(a.z) + w1 * bfhi(b.z); f[8 * c + 6] = w0 * bflo(a.w) + w1 * bflo(b.w); f[8 * c + 7] = w0 * bfhi(a.w) + w1 * bfhi(b.w);
                    continue; }
                const v4u w = *(const GAS v4u*)(O + (size_t)m * DM + g * GW + c * 512 + 8 * lane);
                f[8 * c + 0] = bflo(w.x); f[8 * c + 1] = bfhi(w.x); f[8 * c + 2] = bflo(w.y); f[8 * c + 3] = bfhi(w.y); f[8 * c + 4] = bflo(w.z); f[8 * c + 5] = bfhi(w.z); f[8 * c + 6] = bflo(w.w); f[8 * c + 7] = bfhi(w.w); }
#pragma unroll
            for (int e = 0; e < 16; ++e) s += f[e] * f[e];
            const float rstd = 1.f / sqrtf(wave_sum(s) * (1.f / GW) + EPS);
#pragma unroll
            for (int c = 0; c < 2; ++c) { const float* g8 = go + g * GW + c * 512 + 8 * lane; v4u o;
                o.x = pk2(f[8 * c + 0] * rstd * g8[0], f[8 * c + 1] * rstd * g8[1]); o.y = pk2(f[8 * c + 2] * rstd * g8[2], f[8 * c + 3] * rstd * g8[3]);
                o.z = pk2(f[8 * c + 4] * rstd * g8[4], f[8 * c + 5] * rstd * g8[5]); o.w = pk2(f[8 * c + 6] * rstd * g8[6], f[8 * c + 7] * rstd * g8[7]);
                *(GAS v4u*)(ON + (size_t)m * DM + g * GW + c * 512 + 8 * lane) = o; }
        }
    }
}

#ifndef DUP
#define DUP 0
#endif
#ifndef DUPV
#define DUPV 15
#endif
#ifndef MK_N_LAUNCHES
#define MK_N_LAUNCHES 1
#endif
constexpr int N_PHASES = 22;
struct Args { const float* in[15]; float* out; unsigned char* ws; int ph_lo, ph_hi; };
__global__ void __launch_bounds__(NWAVES * 64, 2) fwd_kernel(Args args) {
    extern __shared__ __attribute__((aligned(16))) unsigned char lds[];
    Frame F;
    F.lds = (LAS unsigned char*)lds;
    F.MISC = (volatile LAS unsigned*)(F.lds + MISC_OFF);
    F.tid = threadIdx.x; F.lane = 0; F.wave = 0;
    F.G = gridDim.x;
    F.ctl = (gu32*)(args.ws + WS_CTL);
    Ptrs P;
    P.x = args.in[0]; P.g_attn = args.in[1]; P.w_in = args.in[2]; P.g_q = args.in[3]; P.g_kv = args.in[4]; P.w_uq = args.in[5]; P.w_uk = args.in[6]; P.w_uv = args.in[7];
    P.b_f = args.in[8]; P.g_out = args.in[9]; P.w_o = args.in[10]; P.g_mlp = args.in[11]; P.w_up = args.in[12]; P.w_down = args.in[13]; P.g_final = args.in[14];
    P.out = args.out; P.ws = args.ws;
    for (int u = F.tid; u < (LDS_BYTES - LDSCTL_OFF) / 4; u += NWAVES * 64) ((LAS unsigned*)(F.lds + LDSCTL_OFF))[u] = 0u;
    __syncthreads();
    XcdBarrier bar; bar.bar = (unsigned*)(F.ctl + CW_BAR); bar.x = 0; bar.st = nullptr;
    if (MK_N_LAUNCHES == 1) bar = xcd_barrier_post((unsigned*)(F.ctl + CW_BAR), F.MISC + 8);
    const int lo = args.ph_lo, hi = args.ph_hi;
#define IN(k) (lo <= (k) && (k) < hi)
#define SEAM(k) do { if (IN(k) && IN((k) + 1)) xcd_barrier(bar); } while (0)

    if (IN(0)) { LFRAME; p0_prologue(Fl, P, 0, 0); } SEAM(0);
    for (int l = 0; l < 2; ++l) {
        const int pb = 1 + 10 * l; const size_t wb = WS_W0 + (size_t)l * WS_WSTRIDE;
        if (false) { LFRAME; p0_prologue(Fl, P, 1, 0); xcd_barrier(bar); }
        const float* xin = (l == 0) ? P.x : wsf(P, WS_X1);
        if (IN(pb + 1)) {
            pg8::Gemm g{wsb(P, WS_XB), wsb(P, wb + WO_IN), S, NMAIN, DM, DM, DM}; pg8::StaticOrder So; So.init(S, NMAIN, F.G, (int)blockIdx.x);
            pg8::EpiBf16<0> E{wsb(P, WS_PROJ), NP, wsf(P, WS_PF), PC_F, (const float*)(F.ctl + CW_SS) + (size_t)(2 * l) * S, 1.f / DM, wsb(P, WS_H), DM, 6, wsf(P, WS_CQ), 11, nullptr, 0, 0};
            pg8::gemm_phase<pg8::EpiBf16<0>, pg8::StaticOrder, true, true>(F.lds + RING_OFF, g, So, E);
        } SEAM(pb + 1);
        if (IN(pb + 2)) {
            const size_t w2 = WS_WUP2 + (size_t)l * 28 * MiB;
            pg8::Gemm g{wsb(P, WS_XB), wsb(P, wb + WO_IN), S, NP, DM, DM, DM, wsb(P, WS_H) + PC_CQ, wsb(P, w2), QLR, wsb(P, WS_H) + PC_CKV, wsb(P, w2 + 12 * MiB), KVLR};
            pg8::MixOrder Sm{F.G, (int)blockIdx.x, NMAIN / 256};
            pg8::EpiMix E{ {wsb(P, WS_PROJ), NP, nullptr, 0, (const float*)(F.ctl + CW_SS) + (size_t)(2 * l) * S, 1.f / DM, nullptr, 0, 0, nullptr, 0, nullptr, 0, 0},
                           {wsb(P, WS_QA), NQA, nullptr, 0, nullptr, 1.f / QLR, nullptr, 0, 0, nullptr, 0, wsf(P, WS_CQ), 0, 28},
                           {wsb(P, WS_KVU), NKVU, nullptr, 0, nullptr, 1.f / KVLR, nullptr, 0, 0, nullptr, 0, wsf(P, WS_CQ), 28, 16} };
            pg8::gemm_phase<pg8::EpiMix, pg8::MixOrder, true, true>(F.lds + RING_OFF, g, Sm, E);
            { const int b0 = (F.G == 256) ? 64 : 0, nb_ = F.G - b0;
              if ((int)blockIdx.x >= b0) { LFRAME; if ((int)blockIdx.x - b0 < NH) cumsum_head(Fl, P, (int)blockIdx.x - b0, l); postproj_rows(Fl, P, l, b0, nb_); } }
        } SEAM(pb + 2);
        if (IN(pb + 4)) { LFRAME; if (FASTMASK != 0) fast_attn_phase(Fl, P, l); if (FASTMASK != 15) slow_attn_phase(Fl, P); if (DUP & 2) { xcd_barrier(bar); fast_attn_phase(Fl, P, l + 2, DUPV); } } SEAM(pb + 4);
        if (IN(pb + 5)) { LFRAME; groupnorm_rows(Fl, P, l);     if (DUP & 4) { xcd_barrier(bar); groupnorm_rows(Fl, P, l); } } SEAM(pb + 5);
        if (IN(pb + 6)) {
            pg8::Gemm g{wsb(P, WS_H), wsb(P, wb + WO_O), S, DM, DM, DM, DM}; pg8::StaticOrder So; So.init(S, DM, F.G, (int)blockIdx.x);
            pg8::EpiResid E{xin, wsf(P, WS_X1), DM, wsb(P, WS_XB), (float*)(F.ctl + CW_SS) + (size_t)(2 * l + 1) * S};
            pg8::gemm_phase<pg8::EpiResid, pg8::StaticOrder, true, true>(F.lds + RING_OFF, g, So, E);
        } SEAM(pb + 6);
        if (IN(pb + 8)) {
            pg8::Gemm g{wsb(P, WS_XB), wsb(P, wb + WO_UP), S, DFF, DM, DM, DM}; pg8::StaticOrder So; So.init(S, DFF, F.G, (int)blockIdx.x);
            pg8::EpiBf16<2> E{wsb(P, WS_U), DFF, nullptr, 0, (const float*)(F.ctl + CW_SS) + (size_t)(2 * l + 1) * S, 1.f / DM};
            pg8::gemm_phase<pg8::EpiBf16<2>, pg8::StaticOrder, true, true>(F.lds + RING_OFF, g, So, E);
        } SEAM(pb + 8);
        if (IN(pb + 9)) {
            pg8::Gemm g{wsb(P, WS_U), wsb(P, wb + WO_DN), S, DM, DFF, DFF, DFF}; pg8::StaticOrder So; So.init(S, DM, F.G, (int)blockIdx.x);
            pg8::EpiResid E{wsf(P, WS_X1), wsf(P, WS_X1), DM, (l == 0) ? wsb(P, WS_XB) : (bf16*)nullptr, (float*)(F.ctl + CW_SS) + (size_t)(2 * l + 2) * S};
            pg8::gemm_phase<pg8::EpiResid, pg8::StaticOrder, true, true>(F.lds + RING_OFF, g, So, E);
        } SEAM(pb + 9);
    }
    if (IN(21)) { LFRAME; rms_rows<true>(Fl, wsf(P, WS_X1), P.g_final, nullptr, P.out); if (DUP & 4) { xcd_barrier(bar); rms_rows<true>(Fl, wsf(P, WS_X1), P.g_final, nullptr, P.out); } }
#undef IN
#undef SEAM
}

extern "C" void kernel_launch(void* const* d_in, const int* in_sizes, int n_in, void* d_out, int out_size, void* d_ws, size_t ws_size, hipStream_t stream) {
    static int grid = 0;
    if (grid == 0) {
        if (n_in != 15 || out_size != S * DM || ws_size < WS_END) { fprintf(stderr, "kernel_launch: unexpected shapes (n_in %d out %d ws %zu, need %zu)\n", n_in, out_size, ws_size, (size_t)WS_END); grid = -1; return; }
        int dev = 0, cus = 0, per_cu = 0;
        if (hipGetDevice(&dev) != hipSuccess || hipDeviceGetAttribute(&cus, hipDeviceAttributeMultiprocessorCount, dev) != hipSuccess) { grid = -1; return; }
        if (hipFuncSetAttribute((const void*)fwd_kernel, hipFuncAttributeMaxDynamicSharedMemorySize, LDS_BYTES) != hipSuccess) { fprintf(stderr, "kernel_launch: hipFuncSetAttribute failed\n"); grid = -1; return; }
        if (hipOccupancyMaxActiveBlocksPerMultiprocessor(&per_cu, (const void*)fwd_kernel, NWAVES * 64, LDS_BYTES) != hipSuccess || per_cu < 1) fprintf(stderr, "kernel_launch: occupancy query says %d\n", per_cu);
        (void)hipGetLastError();
        grid = cus;
    }
    if (grid < 0) return;
    if (hipMemsetAsync((char*)d_ws + WS_CTL, 0, CTL_ZERO_BYTES, stream) != hipSuccess) return;
    Args a{};
    for (int i = 0; i < 15; ++i) a.in[i] = (const float*)d_in[i];
    a.out = (float*)d_out; a.ws = (unsigned char*)d_ws;
    if (MK_N_LAUNCHES == 1) { a.ph_lo = 0; a.ph_hi = N_PHASES; hipLaunchKernelGGL(fwd_kernel, dim3(grid), dim3(NWAVES * 64), LDS_BYTES, stream, a); }
    else { for (int p = 0; p < N_PHASES; ++p) { a.ph_lo = p; a.ph_hi = p + 1; hipLaunchKernelGGL(fwd_kernel, dim3(grid), dim3(NWAVES * 64), LDS_BYTES, stream, a); } }
}
```

```cpp
#include <hip/hip_runtime.h>
#include <cstdio>
#include <cstdint>
namespace pg8 {
#define PG8_LAS __attribute__((address_space(3)))
typedef unsigned short bf16_t;
typedef short bf16x8 __attribute__((ext_vector_type(8)));
typedef float f32x4 __attribute__((ext_vector_type(4)));
typedef unsigned u32x4 __attribute__((ext_vector_type(4)));
constexpr int BM = 256, BK = 64, HALF = 128, HTB = HALF * BK * 2  , STAGE_BYTES = 8 * HTB, NXCD = 8, WGM = 8;

__host__ __device__ __forceinline__ int lds_byte(int r, int c) { const int st = (r >> 4) * 2 + (c >> 5), rr = r & 15, cc = c & 31, ob = rr * 64 + cc * 2; return st * 1024 + (ob ^ (((ob >> 9) & 1) << 5)); }
__host__ __device__ __forceinline__ void stage_rc(int b, int& R, int& C) { const int st = b / 1024, sb = b % 1024, swz = sb ^ (((sb >> 9) & 1) << 5); R = (st >> 1) * 16 + swz / 64; C = (st & 1) * 32 + (swz % 64) / 2; }
__host__ __device__ __forceinline__ int perm32(int rho) { const int n = rho >> 4, i = rho & 15; return 8 * (i >> 2) + 4 * n + (i & 3); }

struct Unit { int pm, pn, ty; };
struct Gemm { const bf16_t* A; const bf16_t* Bt; int M, N, K, lda, ldb; const bf16_t* A1; const bf16_t* B1; int K1; const bf16_t* A2; const bf16_t* B2; int K2; };

struct StaticOrder {
    int nM, nN, nwg, G, c;
    __host__ __device__ void init(int M, int N, int G_, int c_) { nM = M / BM; nN = N / BM; nwg = nM * nN; G = G_; c = c_; }
    __host__ __device__ bool next(int i, Unit& u) const {
        const long L = (long)i * G + c; if (L >= nwg) return false;
        int wgid = (int)L; { const int q = nwg / NXCD, r = nwg % NXCD, xcd = wgid % NXCD, off = wgid / NXCD; wgid = (xcd < r ? xcd * (q + 1) : r * (q + 1) + (xcd - r) * q) + off; }
        const int nig = WGM * nN, gid = wgid / nig, fm = gid * WGM, gsz = (nM - fm) < WGM ? (nM - fm) : WGM;
        u.pm = fm + ((wgid % nig) % gsz); u.pn = (wgid % nig) / gsz; u.ty = 0; return true;
    }
    __device__ __forceinline__ void a_ready(const Unit&) const {}
    __device__ __forceinline__ void done(const Unit&) const {}
};
struct MixOrder {
    int G, c, pn0;
    __device__ bool dec(int L, Unit& u) const {
        if (L < 64) { u.ty = 0; u.pm = L & 31; u.pn = pn0 + (L >> 5); return true; }
        if (L < 256) { const int r = L - 64; u.ty = 1; u.pm = r & 31; u.pn = r >> 5; return true; }
        if (L < 512) { const int r = L - 256; u.ty = 2; u.pm = r & 31; u.pn = r >> 5; return true; }
        return false; }
    __device__ bool next(int i, Unit& u) const {
        if (G == 256) { if (c < 64) return i == 0 ? dec(c, u) : false; const int r = c - 64; if (i == 0) return dec(64 + r, u); if (i == 1) return dec(256 + r, u); if (i == 2 && r < 64) return dec(256 + 192 + r, u); return false; }
        return dec(i * G + c, u); }
    __device__ __forceinline__ void a_ready(const Unit&) const {}
    __device__ __forceinline__ void done(const Unit&) const {}
};


__device__ __forceinline__ unsigned cvt_pk_bf16(float lo, float hi) { unsigned r; asm volatile("v_cvt_pk_bf16_f32 %0, %1, %2" : "=v"(r) : "v"(lo), "v"(hi)); return r; }
template <int ACT> struct EpiBf16 {
    static constexpr bool PERM = true, AFTER_DRAIN = false;
    bf16_t* O; int ldc; float* side; int side_col; const float* ss; float inv_n;
    bf16_t* O2; int ldc2; int ntile2; float* ssp; int hb_n; const float* ssr; int p0, np;
    __device__ __forceinline__ void operator()(const f32x4 (&acc)[2][2][4][2], const Unit& u, int wr, int wc, int fr, int fq) const {
        const int row0 = u.pm * BM + wr * 64 + fr; const int col0 = u.pn * BM + wc * 32 + 8 * fq;
#pragma unroll
        for (int ai = 0; ai < 2; ++ai)
#pragma unroll
            for (int m = 0; m < 4; ++m) { const int row = row0 + ai * HALF + m * 16; bf16_t* rowp = O + (size_t)row * ldc + col0;
                float rs = (ss != nullptr) ? __builtin_amdgcn_rsqf(ss[row] * inv_n + 1e-6f) : 1.f;
                if (ssr != nullptr) { const f32x4* pr = (const f32x4*)(ssr + (size_t)row * 44 + p0); f32x4 a = pr[0];
                    for (int q = 1; q < np / 4; ++q) a += pr[q];
                    rs = __builtin_amdgcn_rsqf(((a[0] + a[1]) + (a[2] + a[3])) * inv_n + 1e-6f); }
#pragma unroll
                for (int bj = 0; bj < 2; ++bj) { f32x4 v0 = acc[ai][bj][m][0] * rs, v1 = acc[ai][bj][m][1] * rs;
                    if (side != nullptr && col0 + bj * HALF == side_col) { *(f32x4*)(side + (size_t)row * 8) = v0; *(f32x4*)(side + (size_t)row * 8 + 4) = v1; }
                    if (ACT == 2) {
#pragma unroll
                        for (int e = 0; e < 4; ++e) { const float a = fmaxf(v0[e], 0.f), b = fmaxf(v1[e], 0.f); v0[e] = a * a; v1[e] = b * b; } }
                    u32x4 w; w.x = cvt_pk_bf16(v0[0], v0[1]); w.y = cvt_pk_bf16(v0[2], v0[3]); w.z = cvt_pk_bf16(v1[0], v1[1]); w.w = cvt_pk_bf16(v1[2], v1[3]);
                    *(u32x4*)(rowp + bj * HALF) = w;
                    if (O2 != nullptr && u.pn < ntile2) { *(u32x4*)(O2 + (size_t)row * ldc2 + col0 + bj * HALF) = w;
                        const int hb = 2 * u.pn + bj;
                        if (hb < hb_n) { float sq = (v0[0] * v0[0] + v0[1] * v0[1]) + (v0[2] * v0[2] + v0[3] * v0[3]) + (v1[0] * v1[0] + v1[1] * v1[1]) + (v1[2] * v1[2] + v1[3] * v1[3]);
                            sq += __shfl_xor(sq, 16); sq += __shfl_xor(sq, 32); if (fq == 0) ssp[(size_t)row * 44 + 4 * hb + wc] = sq; } } } }
    }
};
struct EpiMix {
    static constexpr bool PERM = true, AFTER_DRAIN = false;
    EpiBf16<0> e0, e1, e2;
    __device__ __forceinline__ void operator()(const f32x4 (&acc)[2][2][4][2], const Unit& u, int wr, int wc, int fr, int fq) const {
        if (u.ty == 0) e0(acc, u, wr, wc, fr, fq); else if (u.ty == 1) e1(acc, u, wr, wc, fr, fq); else e2(acc, u, wr, wc, fr, fq);
    }
};
struct EpiResid {
    static constexpr bool PERM = true, AFTER_DRAIN = false;
    const float* R; float* O; int ldc; bf16_t* XB; float* ssq;
    __device__ __forceinline__ void operator()(const f32x4 (&acc)[2][2][4][2], const Unit& u, int wr, int wc, int fr, int fq) const {
        const int row0 = u.pm * BM + wr * 64 + fr; const int col0 = u.pn * BM + wc * 32 + 8 * fq;
#pragma unroll
        for (int ai = 0; ai < 2; ++ai)
#pragma unroll
            for (int m = 0; m < 4; ++m) { const int row = row0 + ai * HALF + m * 16; const size_t off = (size_t)row * ldc + col0; float sq = 0.f;
#pragma unroll
                for (int bj = 0; bj < 2; ++bj) { const f32x4 r0 = *(const f32x4*)(R + off + bj * HALF), r1 = *(const f32x4*)(R + off + bj * HALF + 4);
                    const f32x4 y0 = r0 + acc[ai][bj][m][0], y1 = r1 + acc[ai][bj][m][1];
                    *(f32x4*)(O + off + bj * HALF) = y0; *(f32x4*)(O + off + bj * HALF + 4) = y1;
                    if (XB != nullptr) { u32x4 w; w.x = cvt_pk_bf16(y0[0], y0[1]); w.y = cvt_pk_bf16(y0[2], y0[3]); w.z = cvt_pk_bf16(y1[0], y1[1]); w.w = cvt_pk_bf16(y1[2], y1[3]); *(u32x4*)(XB + off + bj * HALF) = w;
                        sq += (y0[0] * y0[0] + y0[1] * y0[1]) + (y0[2] * y0[2] + y0[3] * y0[3]) + (y1[0] * y1[0] + y1[1] * y1[1]) + (y1[2] * y1[2] + y1[3] * y1[3]); } }
                if (XB != nullptr) { sq += __shfl_xor(sq, 16); sq += __shfl_xor(sq, 32); if (fq == 0) atomicAdd(ssq + row, sq); } }
    }
};

template <class Epi, class Sched, bool ALIGN_EPI = false, bool SP2 = false>
__device__ __forceinline__ void gemm_phase(PG8_LAS unsigned char* lds, const Gemm g, const Sched& S, const Epi& E) {
    int tid_ = threadIdx.x; asm volatile("" : "+v"(tid_));
    const int tid = tid_, wid = __builtin_amdgcn_readfirstlane(tid >> 6), lane = tid & 63, wr = wid >> 2, wc = wid & 3, fr = lane & 15, fq = lane >> 4;
#define PG8_UA(u) ((const char*)((u).ty == 0 ? g.A : (u).ty == 1 ? g.A1 : g.A2))
#define PG8_UB(u) ((const char*)((u).ty == 0 ? g.Bt : (u).ty == 1 ? g.B1 : g.B2))
#define PG8_UK(u) ((u).ty == 0 ? g.K : (u).ty == 1 ? g.K1 : g.K2)
    unsigned voffA[2], voffB[2];
#pragma unroll
    for (int i = 0; i < 2; ++i) { int R, C; stage_rc(tid * 16 + i * 8192, R, C); const int Rb = Epi::PERM ? ((R & ~31) + perm32(R & 31)) : R;
        voffA[i] = (unsigned)(R * g.lda + C) * 2u; voffB[i] = (unsigned)(Rb * g.ldb + C) * 2u; }
    const size_t kstep = (size_t)(BK * 2);
    const size_t hstepA = (size_t)HALF * g.lda * 2, hstepB = (size_t)HALF * g.ldb * 2;
    const size_t tstepA = 2 * hstepA, tstepB = 2 * hstepB;
    const unsigned ldsw = (unsigned)wid * 1024u;
    const int aoff = lds_byte(wr * 64 + fr, fq * 8), boff = lds_byte(wc * 32 + fr, fq * 8);
#define PG8_SA(b, h) (((b) * 2 + (h)) * HTB)
#define PG8_SB(b, h) ((4 + (b) * 2 + (h)) * HTB)
#define PG8_STAGE(bufoff, gbase, voff) do { _Pragma("unroll") for (int _i = 0; _i < 2; ++_i) \
        __builtin_amdgcn_global_load_lds((const unsigned*)((const char*)(gbase) + (voff)[_i]), (PG8_LAS unsigned*)(lds + (bufoff) + ldsw + _i * 8192), 16, 0, 0); } while (0)
#define PG8_LDA(dst, b, h) do { _Pragma("unroll") for (int m = 0; m < 4; ++m) _Pragma("unroll") for (int k = 0; k < 2; ++k) dst[m][k] = *(const PG8_LAS bf16x8*)(lds + PG8_SA(b, h) + aoff + m * 2048 + k * 1024); } while (0)
#define PG8_LDB(dst, b, h) do { _Pragma("unroll") for (int n = 0; n < 2; ++n) _Pragma("unroll") for (int k = 0; k < 2; ++k) dst[n][k] = *(const PG8_LAS bf16x8*)(lds + PG8_SB(b, h) + boff + n * 2048 + k * 1024); } while (0)
#define PG8_MMA(ai, bj, At, Bt) do { __builtin_amdgcn_s_setprio(1); _Pragma("unroll") for (int m = 0; m < 4; ++m) _Pragma("unroll") for (int n = 0; n < 2; ++n) _Pragma("unroll") for (int k = 0; k < 2; ++k) \
        acc[ai][bj][m][n] = __builtin_amdgcn_mfma_f32_16x16x32_bf16(Bt[n][k], At[m][k], acc[ai][bj][m][n], 0, 0, 0); __builtin_amdgcn_s_setprio(0); } while (0)
#define PG8_WAIT_V(n) asm volatile("s_waitcnt vmcnt(" #n ")" ::: "memory")
#define PG8_WAIT_L(n) asm volatile("s_waitcnt lgkmcnt(" #n ")" ::: "memory")
#define PG8_BAR __builtin_amdgcn_s_barrier()
#define PG8_SCHED __builtin_amdgcn_sched_barrier(0)
    Unit cur, nxt; int ui = 0;
    if (!S.next(0, cur)) return;
    f32x4 acc[2][2][4][2];
#pragma unroll
    for (int a = 0; a < 2; ++a)
#pragma unroll
        for (int b = 0; b < 2; ++b)
#pragma unroll
            for (int m = 0; m < 4; ++m)
#pragma unroll
                for (int n = 0; n < 2; ++n) acc[a][b][m][n] = (f32x4){0.f, 0.f, 0.f, 0.f};
    bf16x8 At[4][2], B0[2][2], B1[2][2];
    const char* cA = PG8_UA(cur) + (size_t)cur.pm * tstepA; const char* cB = PG8_UB(cur) + (size_t)cur.pn * tstepB;
    S.a_ready(cur);
    if constexpr (SP2) {
        PG8_STAGE(PG8_SB(0, 0), cB, voffB); PG8_STAGE(PG8_SB(0, 1), cB + hstepB, voffB); PG8_STAGE(PG8_SA(0, 0), cA, voffA); PG8_STAGE(PG8_SA(0, 1), cA + hstepA, voffA);
        if (wr == 1) PG8_BAR;
        PG8_WAIT_V(2); PG8_BAR;
        PG8_STAGE(PG8_SB(1, 0), cB + kstep, voffB); PG8_STAGE(PG8_SA(1, 0), cA + kstep, voffA); PG8_STAGE(PG8_SB(1, 1), cB + hstepB + kstep, voffB);
        PG8_WAIT_V(6); PG8_BAR;
    } else {
        PG8_STAGE(PG8_SB(0, 0), cB, voffB); PG8_STAGE(PG8_SA(0, 0), cA, voffA); PG8_STAGE(PG8_SB(0, 1), cB + hstepB, voffB); PG8_STAGE(PG8_SA(0, 1), cA + hstepA, voffA);
        if (wr == 1) PG8_BAR;
        PG8_WAIT_V(4); PG8_BAR;
        PG8_STAGE(PG8_SB(1, 0), cB + kstep, voffB); PG8_STAGE(PG8_SA(1, 0), cA + kstep, voffA); PG8_STAGE(PG8_SB(1, 1), cB + hstepB + kstep, voffB);
        PG8_WAIT_V(6); PG8_BAR;
    }
    for (;;) {
        const bool has_next = S.next(ui + 1, nxt);
        const char* nA = has_next ? PG8_UA(nxt) + (size_t)nxt.pm * tstepA : cA; const char* nB = has_next ? PG8_UB(nxt) + (size_t)nxt.pn * tstepB : cB;
        const int nt = PG8_UK(cur) / BK;
        for (int t = 0; t < nt; t += 2) {
            const bool last = (t == nt - 2);
            const char* a1 = cA + (size_t)(t + 1) * kstep;
            const char* a2 = last ? nA : cA + (size_t)(t + 2) * kstep; const char* b2 = last ? nB : cB + (size_t)(t + 2) * kstep;
            const char* a3 = a2 + kstep; const char* b3 = b2 + kstep;
            if (last && has_next) S.a_ready(nxt);
            if constexpr (SP2) {
            PG8_LDB(B0, 0, 0); PG8_LDB(B1, 0, 1); PG8_SCHED; PG8_LDA(At, 0, 0); PG8_STAGE(PG8_SA(1, 1), a1 + hstepA, voffA);
            PG8_WAIT_V(8); PG8_WAIT_L(0); PG8_BAR; PG8_MMA(0, 0, At, B0); PG8_MMA(0, 1, At, B1); PG8_BAR; PG8_SCHED;
            PG8_LDA(At, 0, 1); PG8_STAGE(PG8_SB(0, 0), b2, voffB); PG8_STAGE(PG8_SB(0, 1), b2 + hstepB, voffB); PG8_STAGE(PG8_SA(0, 0), a2, voffA);
            PG8_WAIT_V(8); PG8_WAIT_L(0); PG8_BAR; PG8_MMA(1, 0, At, B0); PG8_MMA(1, 1, At, B1); PG8_BAR; PG8_SCHED;
            PG8_LDB(B0, 1, 0); PG8_LDB(B1, 1, 1); PG8_SCHED; PG8_LDA(At, 1, 0); PG8_STAGE(PG8_SA(0, 1), a2 + hstepA, voffA);
            PG8_WAIT_V(8); PG8_WAIT_L(0); PG8_BAR; PG8_MMA(0, 0, At, B0); PG8_MMA(0, 1, At, B1); PG8_BAR; PG8_SCHED;
            PG8_LDA(At, 1, 1); PG8_STAGE(PG8_SB(1, 0), b3, voffB); PG8_STAGE(PG8_SB(1, 1), b3 + hstepB, voffB); PG8_STAGE(PG8_SA(1, 0), a3, voffA);
            PG8_WAIT_V(8); PG8_WAIT_L(0); PG8_BAR; PG8_MMA(1, 0, At, B0); PG8_MMA(1, 1, At, B1); PG8_BAR; PG8_SCHED;
            } else {
            PG8_LDB(B0, 0, 0); PG8_SCHED; PG8_LDA(At, 0, 0); PG8_STAGE(PG8_SA(1, 1), a1 + hstepA, voffA);
            PG8_WAIT_L(8); PG8_BAR; PG8_WAIT_L(0); PG8_MMA(0, 0, At, B0); PG8_BAR; PG8_SCHED;
            PG8_LDB(B1, 0, 1); PG8_STAGE(PG8_SB(0, 0), b2, voffB);
            PG8_BAR; PG8_WAIT_L(0); PG8_MMA(0, 1, At, B1); PG8_BAR;
            PG8_LDA(At, 0, 1); PG8_STAGE(PG8_SA(0, 0), a2, voffA);
            PG8_BAR; PG8_WAIT_L(0); PG8_MMA(1, 0, At, B0); PG8_BAR; PG8_SCHED;
            PG8_STAGE(PG8_SB(0, 1), b2 + hstepB, voffB);
            PG8_WAIT_V(6); PG8_BAR; PG8_MMA(1, 1, At, B1); PG8_BAR;
            PG8_LDB(B0, 1, 0); PG8_SCHED; PG8_LDA(At, 1, 0); PG8_STAGE(PG8_SA(0, 1), a2 + hstepA, voffA);
            PG8_WAIT_L(8); PG8_BAR; PG8_WAIT_L(0); PG8_MMA(0, 0, At, B0); PG8_BAR; PG8_SCHED;
            PG8_LDB(B1, 1, 1); PG8_STAGE(PG8_SB(1, 0), b3, voffB);
            PG8_BAR; PG8_WAIT_L(0); PG8_MMA(0, 1, At, B1); PG8_BAR;
            PG8_LDA(At, 1, 1); PG8_STAGE(PG8_SA(1, 0), a3, voffA);
            PG8_BAR; PG8_WAIT_L(0); PG8_MMA(1, 0, At, B0); PG8_BAR; PG8_SCHED;
            PG8_STAGE(PG8_SB(1, 1), b3 + hstepB, voffB);
            PG8_WAIT_V(6); PG8_BAR; PG8_MMA(1, 1, At, B1); PG8_BAR;
            }
        }
        if constexpr (ALIGN_EPI) { if (wr == 0) PG8_BAR; }
        if constexpr (!Epi::AFTER_DRAIN) { E(acc, cur, wr, wc, fr, fq); S.done(cur); }
        if (!has_next) break;
#pragma unroll
        for (int a = 0; a < 2; ++a)
#pragma unroll
            for (int b = 0; b < 2; ++b)
#pragma unroll
                for (int m = 0; m < 4; ++m)
#pragma unroll
                    for (int n = 0; n < 2; ++n) acc[a][b][m][n] = (f32x4){0.f, 0.f, 0.f, 0.f};
        cur = nxt; cA = nA; cB = nB; ++ui;
        if constexpr (ALIGN_EPI) { if (wr == 1) PG8_BAR; }
    }
    PG8_WAIT_V(0);
    if constexpr (!ALIGN_EPI) { if (wr == 0) PG8_BAR; }
    PG8_BAR;
    if constexpr (Epi::AFTER_DRAIN) { E.fused(acc, cur, wr, wc, fr, fq, lds, wid, lane); S.done(cur); }
#undef PG8_UA
#undef PG8_UB
#undef PG8_UK
#undef PG8_SA
#undef PG8_SB
#undef PG8_STAGE
#undef PG8_LDA
#undef PG8_LDB
#undef PG8_MMA
#undef PG8_WAIT_V
#undef PG8_WAIT_L
#undef PG8_BAR
#undef PG8_SCHED
}
}
#define GAS __attribute__((address_space(1)))
#define LAS __attribute__((address_space(3)))
typedef unsigned short bf16;
typedef unsigned v4u __attribute__((ext_vector_type(4)));
typedef float f32x4 __attribute__((ext_vector_type(4)));
typedef short bf16x8 __attribute__((ext_vector_type(8)));
typedef GAS unsigned gu32;
typedef GAS unsigned long long gu64;
#define RLX_AGENT __ATOMIC_RELAXED, __HIP_MEMORY_SCOPE_AGENT
#define LDS_WAIT() asm volatile("s_waitcnt lgkmcnt(0)" ::: "memory")
#define VM_WAIT() asm volatile("s_waitcnt vmcnt(0)" ::: "memory")
__device__ __forceinline__ unsigned long long rt() { return __builtin_amdgcn_s_memrealtime(); }
__device__ __forceinline__ unsigned f2bf(float f) { unsigned u = __builtin_bit_cast(unsigned, f); return (u + 0x7fffu + ((u >> 16) & 1u)) >> 16; }
__device__ __forceinline__ unsigned pk2(float lo, float hi) { return f2bf(lo) | (f2bf(hi) << 16); }

#define XB_TMO      128
#define XB_XCNT(j)  (256  + 64 * (j))
#define XB_XSUB(j)  (1280 + 64 * (j))
#define XB_XGEN(j)  (2304 + 64 * (j))
#define XB_TOP      3328
#define XB_TOPGEN   3392
#define XCD_BAR_WORDS 3456
#define XB_SPIN_CAP (1u << 18)

__device__ __forceinline__ unsigned xb_ld(unsigned* p)              { return __hip_atomic_load(p, __ATOMIC_RELAXED, __HIP_MEMORY_SCOPE_AGENT); }
__device__ __forceinline__ unsigned xb_add(unsigned* p, unsigned v) { return __hip_atomic_fetch_add(p, v, __ATOMIC_RELAXED, __HIP_MEMORY_SCOPE_AGENT); }
__device__ __forceinline__ unsigned xb_xcc_id() { return (unsigned)__builtin_amdgcn_s_getreg((3 << 11) | 20) & 0xFu; }
#define XB_SPIN(cond, bar) do { unsigned _sp = 0; while (cond) { __builtin_amdgcn_s_sleep(1); \
    if ((++_sp & 255u) == 0u) { if (xb_ld(&(bar)[XB_TMO])) break; if (_sp > XB_SPIN_CAP) { atomicAdd(&(bar)[XB_TMO], 1u); break; } } } } while (0)

struct XcdBarrier {
    unsigned* bar; unsigned x;
    volatile LAS unsigned* st;
};

__device__ __forceinline__ XcdBarrier xcd_barrier_post(unsigned* bar, volatile LAS unsigned* st) {
    XcdBarrier b; b.bar = bar; b.x = xb_xcc_id(); b.st = st;
    if (threadIdx.x == 0) (void)xb_add(&bar[XB_XCNT(b.x)], 1u);
    return b;
}
__device__ __forceinline__ void xcd_barrier_complete(unsigned* bar, unsigned x, unsigned& nloc, unsigned& nx) {
    const unsigned G = gridDim.x * gridDim.y * gridDim.z;
    unsigned sum, cnt, mine, sp = 0u;
    for (;;) {
        sum = 0u; cnt = 0u; mine = 0u;
#pragma unroll
        for (unsigned j = 0; j < 16; ++j) { const unsigned c = xb_ld(&bar[XB_XCNT(j)]); sum += c; cnt += (c > 0u) ? 1u : 0u; mine = (j == x) ? c : mine; }
        if (sum == G) break;
        __builtin_amdgcn_s_sleep(1);
        if ((++sp & 255u) == 0u) { if (xb_ld(&bar[XB_TMO])) break; if (sp > XB_SPIN_CAP) { atomicAdd(&bar[XB_TMO], 1u); break; } }
    }
    nloc = mine > 0u ? mine : 1u; nx = cnt > 0u ? cnt : 1u;
}

__device__ __forceinline__ void xcd_barrier(const XcdBarrier& b) {
    asm volatile("s_waitcnt vmcnt(0)" ::: "memory");
    __syncthreads();
    if (threadIdx.x == 0) {
        unsigned* bar = b.bar;
        __builtin_amdgcn_s_waitcnt(0);
        unsigned nloc = b.st[0], nx = b.st[1];
        if (nloc == 0u) { xcd_barrier_complete(bar, b.x, nloc, nx); b.st[0] = nloc; b.st[1] = nx; }
        const unsigned old = xb_add(&bar[XB_XSUB(b.x)], 1u);
        const unsigned gen = old / nloc;
        if (old + 1u == (gen + 1u) * nloc) {
            __builtin_amdgcn_fence(__ATOMIC_RELEASE, "agent");
            asm volatile("s_waitcnt vmcnt(0)" ::: "memory");
            const unsigned og = xb_add(&bar[XB_TOP], 1u);
            const unsigned tg = og / nx;
            if (og + 1u == (tg + 1u) * nx) xb_add(&bar[XB_TOPGEN], 1u);
            else XB_SPIN(xb_ld(&bar[XB_TOPGEN]) == tg, bar);
            __builtin_amdgcn_fence(__ATOMIC_ACQUIRE, "agent");
            xb_add(&bar[XB_XGEN(b.x)], 1u);
            asm volatile("s_waitcnt vmcnt(0)" ::: "memory");
        } else {
            XB_SPIN(xb_ld(&bar[XB_XGEN(b.x)]) == gen, bar);
            __builtin_amdgcn_fence(__ATOMIC_ACQUIRE, "agent");
            asm volatile("s_waitcnt vmcnt(0)" ::: "memory");
        }
    }
    __syncthreads();
}

constexpr int NWAVES = 8;
constexpr int S = 8192, DM = 4096, NP = 10752, INC = 10696, QLR = 896, KVLR = 512, NQA = 1536, NKVU = 2048, DFF = 16384, NH = 8, HD = 128, GW = 1024;
constexpr int NMAIN = 10240;
constexpr int PC_CQ = 0, PC_CKV = 896, PC_KR = 1408, PC_F = 1472, PC_B = 1536, PC_C = 4608, PC_D = 7680;
constexpr float EPS = 1e-6f;
constexpr float LOG2E = 1.4426950408889634f, LN2 = 0.6931471805599453f;
constexpr size_t MiB = 1u << 20;
constexpr size_t WS_CTL = 0, CTL_ZERO_BYTES = 1 * MiB;
constexpr size_t WS_COS64 = 1 * MiB, WS_SIN64 = 2 * MiB, WS_COS32 = 3 * MiB, WS_SIN32 = 3 * MiB + 512 * 1024;
constexpr size_t WS_PF = 4 * MiB, WS_LOGF = 4 * MiB + 256 * 1024, WS_CK = 4 * MiB + 512 * 1024, WS_LSE = 5 * MiB, WS_LSEA = 5 * MiB + 768 * 1024;
constexpr size_t WS_W0 = 8 * MiB, WS_WSTRIDE = 378 * MiB;
constexpr size_t WO_IN = 0, WO_UQ = 84 * MiB, WO_UKV = 87 * MiB, WO_O = 89 * MiB, WO_UP = 121 * MiB, WO_DN = 249 * MiB;
constexpr size_t WS_H = 764 * MiB, WS_PROJ = 828 * MiB, WS_CQ = 996 * MiB, WS_CKV = 1010 * MiB, WS_QA = 1018 * MiB, WS_KVU = 1042 * MiB, WS_KR = 1074 * MiB;
constexpr size_t WS_O = 1075 * MiB, WS_OB = 1139 * MiB, WS_X1 = 1187 * MiB, WS_U = 1315 * MiB, WS_XB = 1571 * MiB, WS_PA = 1635 * MiB, WS_WUP2 = 1667 * MiB  , WS_END = 1723 * MiB;
static_assert((size_t)NP * DM * 2 <= 84 * MiB && (size_t)S * NP * 2 <= 168 * MiB && (size_t)S * DFF * 2 <= 256 * MiB, "map");
constexpr int CW_TMO = 0, CW_CODE = 1, CW_BAR = 4096, CW_QUEUE = 16384, CW_SS = 65536, CW_KN = 61440, CW_SSQ = 131072;
constexpr int RING_OFF = 0, RING_BYTES = 131072;
constexpr int LDSCTL_OFF = RING_BYTES, MISC_OFF = LDSCTL_OFF + 320;
constexpr int LDS_BYTES = 147456;

struct Frame {
    LAS unsigned char* lds;
    volatile LAS unsigned* MISC;
    gu32* ctl;
    int tid, lane, wave, G;
};

__device__ __forceinline__ float wave_sum(float v) {
#pragma unroll
    for (int o = 1; o < 64; o <<= 1) v += __shfl_xor(v, o);
    return v;
}
__device__ __forceinline__ int opaque(int v) { asm volatile("" : "+v"(v)); return v; }
#define LFRAME Frame Fl = F; Fl.tid = opaque(F.tid); Fl.lane = Fl.tid & 63; Fl.wave = __builtin_amdgcn_readfirstlane(Fl.tid >> 6)
__device__ __forceinline__ float bf2f(unsigned short b) { return __builtin_bit_cast(float, (unsigned)b << 16); }
__device__ __forceinline__ float bflo(unsigned w) { return __builtin_bit_cast(float, w << 16); }
__device__ __forceinline__ float bfhi(unsigned w) { return __builtin_bit_cast(float, w & 0xffff0000u); }

__device__ __forceinline__ unsigned cvtpk_rne(float lo, float hi) { unsigned r; asm volatile("v_cvt_pk_bf16_f32 %0, %1, %2" : "=v"(r) : "v"(lo), "v"(hi)); return r; }
__device__ __forceinline__ void p0_item64(const float* W, int K, int N, bf16* WT, const float* gk, int item, int nblk, int lane, int ldw = 0, bool win_layout = false) {
    const int kb = item / nblk, nb = item - kb * nblk, kq = lane >> 4, c = lane & 15;
    const int kbase = 64 * kb + 16 * kq, n = 64 * nb + 4 * c; const bool ok = n < N;
    const int nbd = !win_layout ? nb : (nb <= 22 ? nb : (nb <= 166 ? nb + 1 : 23)); const int nd = 64 * nbd + 4 * c;
    f32x4 v[16];
    const float* src = W + (size_t)kbase * N + n;
#pragma unroll
    for (int i = 0; i < 16; ++i) v[i] = ok ? __builtin_nontemporal_load((const GAS f32x4*)(src + (size_t)i * N)) : (f32x4){0.f, 0.f, 0.f, 0.f};
    if (gk != nullptr) {
#pragma unroll
        for (int i = 0; i < 4; ++i) { const f32x4 g = *(const GAS f32x4*)(gk + kbase + 4 * i); v[4 * i] *= g.x; v[4 * i + 1] *= g.y; v[4 * i + 2] *= g.z; v[4 * i + 3] *= g.w; }
    }
#pragma unroll
    for (int j = 0; j < 4; ++j) {
        v4u lo, hi;
        lo.x = cvtpk_rne(v[0][j], v[1][j]); lo.y = cvtpk_rne(v[2][j], v[3][j]); lo.z = cvtpk_rne(v[4][j], v[5][j]); lo.w = cvtpk_rne(v[6][j], v[7][j]);
        hi.x = cvtpk_rne(v[8][j], v[9][j]); hi.y = cvtpk_rne(v[10][j], v[11][j]); hi.z = cvtpk_rne(v[12][j], v[13][j]); hi.w = cvtpk_rne(v[14][j], v[15][j]);
        bf16* dst = WT + (size_t)(nd + j) * (ldw ? ldw : K) + kbase;
        *(GAS v4u*)dst = lo; *(GAS v4u*)(dst + 8) = hi;
    }
}
__device__ __forceinline__ void sincos_d(double a, float& sn, float& cs) {
    const double k = __builtin_rint(a * 0.15915494309189535);
    double r = __builtin_fma(-k, 6.283185307179586, a); r = __builtin_fma(-k, 2.4492935982947064e-16, r);
    const double q = __builtin_rint(r * 0.6366197723675814);
    double x = __builtin_fma(-q, 1.5707963267948966, r); x = __builtin_fma(-q, 6.123233995736766e-17, x);
    const double x2 = x * x;
    double sp = 1.0 / 6227020800.0; sp = sp * x2 - 1.0 / 39916800.0; sp = sp * x2 + 1.0 / 362880.0; sp = sp * x2 - 1.0 / 5040.0; sp = sp * x2 + 1.0 / 120.0; sp = sp * x2 - 1.0 / 6.0; sp = sp * x2 * x + x;
    double cp = -1.0 / 87178291200.0; cp = cp * x2 + 1.0 / 479001600.0; cp = cp * x2 - 1.0 / 3628800.0; cp = cp * x2 + 1.0 / 40320.0; cp = cp * x2 - 1.0 / 720.0; cp = cp * x2 + 1.0 / 24.0; cp = cp * x2 - 0.5; cp = cp * x2 + 1.0;
    const int qi = ((int)q) & 3;
    const double s = (qi == 0) ? sp : (qi == 1) ? cp : (qi == 2) ? -sp : -cp;
    const double c = (qi == 0) ? cp : (qi == 1) ? -sp : (qi == 2) ? -cp : sp;
    sn = (float)s; cs = (float)c;
}
__device__ __forceinline__ double powi_d(double c, int i) { double r = 1.0, b = c; for (int e = 0; e < 5; ++e) { if (i & (1 << e)) r *= b; b *= b; } return r; }

struct Ptrs {
    const float *x, *g_attn, *w_in, *g_q, *g_kv, *w_uq, *w_uk, *w_uv, *b_f, *g_out, *w_o, *g_mlp, *w_up, *w_down, *g_final;
    float* out; unsigned char* ws;
};
__device__ __forceinline__ bf16* wsb(const Ptrs& P, size_t off) { return (bf16*)(P.ws + off); }
__device__ __forceinline__ float* wsf(const Ptrs& P, size_t off) { return (float*)(P.ws + off); }

__device__ __forceinline__ void p0_prologue(Frame& F, const Ptrs& P, int lsel, int part) {
    const int gw = blockIdx.x * NWAVES + F.wave, NGW = F.G * NWAVES;
    constexpr int I_IN = (DM / 64) * (NP / 64), I_UQ = (QLR / 64) * (NQA / 64), I_UK = (KVLR / 64) * (GW / 64), I_O = (DM / 64) * (DM / 64), I_UP = (DM / 64) * (DFF / 64), I_DN = (DFF / 64) * (DM / 64);
    constexpr int PER = I_IN + I_UQ + 2 * I_UK + I_O + I_UP + I_DN;
    constexpr int P0N = I_IN + I_UQ + 2 * I_UK;
    const int lo_ = (part == 0) ? 0 : (part == 1) ? P0N : (part == 2) ? P0N + I_O : P0N + I_O + I_UP, hi_ = (part == 0) ? P0N : (part == 1) ? P0N + I_O : (part == 2) ? P0N + I_O + I_UP : PER;
    for (int it = lo_ + gw; it < hi_; it += NGW) {
        const int l = lsel; int r = it; const size_t wb = WS_W0 + (size_t)l * WS_WSTRIDE;
        if (r < I_IN) { p0_item64(P.w_in + (size_t)l * DM * INC, DM, INC, wsb(P, wb + WO_IN), P.g_attn + (size_t)l * DM, r, NP / 64, F.lane, 0, true); continue; } r -= I_IN;
        if (r < I_UQ) { p0_item64(P.w_uq + (size_t)l * QLR * NQA, QLR, NQA, wsb(P, WS_WUP2 + (size_t)l * 28 * MiB), P.g_q + (size_t)l * QLR, r, NQA / 64, F.lane, DM); continue; } r -= I_UQ;
        if (r < I_UK) { p0_item64(P.w_uk + (size_t)l * KVLR * GW, KVLR, GW, wsb(P, WS_WUP2 + (size_t)l * 28 * MiB + 12 * MiB), P.g_kv + (size_t)l * KVLR, r, GW / 64, F.lane, DM); continue; } r -= I_UK;
        if (r < I_UK) { p0_item64(P.w_uv + (size_t)l * KVLR * GW, KVLR, GW, wsb(P, WS_WUP2 + (size_t)l * 28 * MiB + 12 * MiB) + (size_t)GW * DM, P.g_kv + (size_t)l * KVLR, r, GW / 64, F.lane, DM); continue; } r -= I_UK;
        if (r < I_O) { p0_item64(P.w_o + (size_t)l * DM * DM, DM, DM, wsb(P, wb + WO_O), nullptr, r, DM / 64, F.lane); continue; } r -= I_O;
        if (r < I_UP) { p0_item64(P.w_up + (size_t)l * DM * DFF, DM, DFF, wsb(P, wb + WO_UP), P.g_mlp + (size_t)l * DM, r, DFF / 64, F.lane); continue; } r -= I_UP;
        p0_item64(P.w_down + (size_t)l * DFF * DM, DFF, DM, wsb(P, wb + WO_DN), nullptr, r, DM / 64, F.lane);
    }
    if (lsel == 0 && part == 0) {
    { float* ss0 = (float*)(F.ctl + CW_SS); bf16* XB = wsb(P, WS_XB);
      for (int m = gw; m < S; m += NGW) {
        const GAS f32x4* xr = (const GAS f32x4*)(P.x + (size_t)m * DM) + F.lane; GAS unsigned long long* o8 = (GAS unsigned long long*)(XB + (size_t)m * DM) + F.lane; float sq = 0.f;
#pragma unroll
        for (int j = 0; j < 16; ++j) { const f32x4 v = xr[64 * j]; sq += (v.x * v.x + v.y * v.y) + (v.z * v.z + v.w * v.w); o8[64 * j] = (unsigned long long)cvtpk_rne(v.x, v.y) | ((unsigned long long)cvtpk_rne(v.z, v.w) << 32); }
        sq = wave_sum(sq); if (F.lane == 0) ss0[m] = sq; } }
    const int gt = blockIdx.x * (NWAVES * 64) + F.tid, NGT = F.G * NWAVES * 64;
    for (int e = gt; e < S * 48; e += NGT) {
        const int pos = e / 48, j = e % 48;
        float sn, cs;
        if (j < 32) { const double inv = powi_d(0.6636012376960885, j); sincos_d((double)pos * inv, sn, cs); wsf(P, WS_COS64)[pos * 32 + j] = cs; wsf(P, WS_SIN64)[pos * 32 + j] = sn; }
        else { const int i = j - 32; const double inv = powi_d(0.44036660267178046, i); sincos_d((double)pos * inv, sn, cs); wsf(P, WS_COS32)[pos * 16 + i] = cs; wsf(P, WS_SIN32)[pos * 16 + i] = sn; }
    }
    }
}

__device__ __forceinline__ void conv_range(Frame& F, const Ptrs& P, int lsel, int it_lo, int it_hi) {
    constexpr int I_IN = (DM / 64) * (NP / 64), I_UQ = (QLR / 64) * (NQA / 64), I_UK = (KVLR / 64) * (GW / 64), I_O = (DM / 64) * (DM / 64), I_UP = (DM / 64) * (DFF / 64);
    const int l = lsel; const size_t wb = WS_W0 + (size_t)l * WS_WSTRIDE;
    for (int it = it_lo + F.wave; it < it_hi; it += NWAVES) {
        int r = it;
        if (r < I_IN) { p0_item64(P.w_in + (size_t)l * DM * INC, DM, INC, wsb(P, wb + WO_IN), P.g_attn + (size_t)l * DM, r, NP / 64, F.lane, 0, true); continue; } r -= I_IN;
        if (r < I_UQ) { p0_item64(P.w_uq + (size_t)l * QLR * NQA, QLR, NQA, wsb(P, WS_WUP2 + (size_t)l * 28 * MiB), P.g_q + (size_t)l * QLR, r, NQA / 64, F.lane, DM); continue; } r -= I_UQ;
        if (r < I_UK) { p0_item64(P.w_uk + (size_t)l * KVLR * GW, KVLR, GW, wsb(P, WS_WUP2 + (size_t)l * 28 * MiB + 12 * MiB), P.g_kv + (size_t)l * KVLR, r, GW / 64, F.lane, DM); continue; } r -= I_UK;
        if (r < I_UK) { p0_item64(P.w_uv + (size_t)l * KVLR * GW, KVLR, GW, wsb(P, WS_WUP2 + (size_t)l * 28 * MiB + 12 * MiB) + (size_t)GW * DM, P.g_kv + (size_t)l * KVLR, r, GW / 64, F.lane, DM); continue; } r -= I_UK;
        if (r < I_O) { p0_item64(P.w_o + (size_t)l * DM * DM, DM, DM, wsb(P, wb + WO_O), nullptr, r, DM / 64, F.lane); continue; } r -= I_O;
        if (r < I_UP) { p0_item64(P.w_up + (size_t)l * DM * DFF, DM, DFF, wsb(P, wb + WO_UP), P.g_mlp + (size_t)l * DM, r, DFF / 64, F.lane); continue; } r -= I_UP;
        p0_item64(P.w_down + (size_t)l * DFF * DM, DFF, DM, wsb(P, wb + WO_DN), nullptr, r, DM / 64, F.lane);
    }
}

template <bool F32OUT>
__device__ __forceinline__ void rms_rows(Frame& F, const float* X, const float* g, bf16* ob, float* of) {
    const int gw = blockIdx.x * NWAVES + F.wave, NGW = F.G * NWAVES;
    for (int m = gw; m < S; m += NGW) {
        const GAS f32x4* xr = (const GAS f32x4*)(X + (size_t)m * DM) + F.lane;
        f32x4 v[16]; float s = 0.f;
#pragma unroll
        for (int j = 0; j < 16; ++j) { v[j] = xr[64 * j]; s += (v[j].x * v[j].x + v[j].y * v[j].y) + (v[j].z * v[j].z + v[j].w * v[j].w); }
        const float rstd = 1.f / sqrtf(wave_sum(s) * (1.f / DM) + EPS);
        const GAS f32x4* gr = (const GAS f32x4*)g + F.lane;
        if (F32OUT) { GAS f32x4* o = (GAS f32x4*)(of + (size_t)m * DM) + F.lane;
#pragma unroll
            for (int j = 0; j < 16; ++j) { const f32x4 gg = gr[64 * j]; o[64 * j] = v[j] * rstd * gg; } }
        else { GAS unsigned long long* o8 = (GAS unsigned long long*)(ob + (size_t)m * DM) + F.lane;
#pragma unroll
            for (int j = 0; j < 16; ++j) { const f32x4 gg = gr[64 * j]; const f32x4 y = v[j] * rstd * gg;
                o8[64 * j] = (unsigned long long)pk2(y.x, y.y) | ((unsigned long long)pk2(y.z, y.w) << 32); } }
    }
}

__device__ __forceinline__ void postproj_rows(Frame& F, const Ptrs& P, int l, int b0, int nb_) {
    const int gw = ((int)blockIdx.x - b0) * NWAVES + F.wave, NGW = nb_ * NWAVES, lane = F.lane;
    bf16* PROJ = wsb(P, WS_PROJ); bf16* CQ = wsb(P, WS_CQ); bf16* CKV = wsb(P, WS_CKV); bf16* KR = wsb(P, WS_KR);
    const float* gq = P.g_q + l * QLR; const float* gkv = P.g_kv + l * KVLR; const float* bfp = P.b_f + l * NH;
    const float* C64 = wsf(P, WS_COS64); const float* S64 = wsf(P, WS_SIN64); const float* C32 = wsf(P, WS_COS32); const float* S32 = wsf(P, WS_SIN32);
    float knmax[2] = {0.f, 0.f};
    for (int m = gw; m < S; m += NGW) {
        bf16* prow = PROJ + (size_t)m * NP;
        if (lane < 32) {
            const float t1 = bf2f(prow[PC_KR + lane]), t2 = bf2f(prow[PC_KR + 32 + lane]); const float c = C64[m * 32 + lane], sn = S64[m * 32 + lane];
            KR[(size_t)m * 64 + lane] = (bf16)f2bf(t1 * c - t2 * sn); KR[(size_t)m * 64 + 32 + lane] = (bf16)f2bf(t1 * sn + t2 * c);
        }
        {
            const int chunk = lane >> 2, part = lane & 3; bf16* cp = prow + PC_B + (chunk >> 3) * GW + (chunk & 7) * HD + 4 * part;
            const unsigned long long w1 = *(const GAS unsigned long long*)cp, w2 = *(const GAS unsigned long long*)(cp + 16);
            const f32x4 c = *(const GAS f32x4*)(C32 + (size_t)m * 16 + 4 * part), sn = *(const GAS f32x4*)(S32 + (size_t)m * 16 + 4 * part);
            const float a0 = bflo((unsigned)w1), a1 = bfhi((unsigned)w1), a2 = bflo((unsigned)(w1 >> 32)), a3 = bfhi((unsigned)(w1 >> 32));
            const float b0 = bflo((unsigned)w2), b1 = bfhi((unsigned)w2), b2 = bflo((unsigned)(w2 >> 32)), b3 = bfhi((unsigned)(w2 >> 32));
            *(GAS unsigned long long*)cp = (unsigned long long)pk2(a0 * c.x - b0 * sn.x, a1 * c.y - b1 * sn.y) | ((unsigned long long)pk2(a2 * c.z - b2 * sn.z, a3 * c.w - b3 * sn.w) << 32);
            *(GAS unsigned long long*)(cp + 16) = (unsigned long long)pk2(a0 * sn.x + b0 * c.x, a1 * sn.y + b1 * c.y) | ((unsigned long long)pk2(a2 * sn.z + b2 * c.z, a3 * sn.w + b3 * c.w) << 32);
        }
        {
#pragma unroll
            for (int c = 0; c < 2; ++c) { const v4u w = *(const GAS v4u*)(prow + PC_D + GW + c * 512 + 8 * lane);
                float sq = bflo(w.x) * bflo(w.x) + bfhi(w.x) * bfhi(w.x) + bflo(w.y) * bflo(w.y) + bfhi(w.y) * bfhi(w.y) + bflo(w.z) * bflo(w.z) + bfhi(w.z) * bfhi(w.z) + bflo(w.w) * bflo(w.w) + bfhi(w.w) * bfhi(w.w);
                sq += __shfl_xor(sq, 1); sq += __shfl_xor(sq, 2); sq += __shfl_xor(sq, 4); sq += __shfl_xor(sq, 8);
                knmax[c] = fmaxf(knmax[c], sq); }
        }
    }
    {
        LAS float* red = (LAS float*)(F.lds + RING_OFF);
        if ((lane & 15) == 0) { red[F.wave * 8 + (lane >> 4)] = knmax[0]; red[F.wave * 8 + 4 + (lane >> 4)] = knmax[1]; }
        __syncthreads();
        if (F.tid < NH) { float mx = 0.f;
#pragma unroll
            for (int w = 0; w < NWAVES; ++w) mx = fmaxf(mx, red[w * 8 + F.tid]);
            __hip_atomic_fetch_max(F.ctl + CW_KN + 16 * (l & 1) + F.tid, __builtin_bit_cast(unsigned, mx), __ATOMIC_RELAXED, __HIP_MEMORY_SCOPE_AGENT); }
        __syncthreads();
    }
}

__device__ __forceinline__ void cumsum_head(Frame& F, const Ptrs& P, int h, int l) {
    const float* PFp = wsf(P, WS_PF); const float bfh = P.b_f[l * NH + h]; float* CK = wsf(P, WS_CK) + (size_t)h * S;
    LAS float* wt = (LAS float*)(F.lds + RING_OFF);
    float v[16]; float run = 0.f;
#pragma unroll
    for (int j = 0; j < 16; ++j) { const float z = PFp[(size_t)(16 * F.tid + j) * 8 + h] + bfh; run += fminf(z, 0.f) - log1pf(expf(-fabsf(z))); v[j] = run; }
    float inc = run;
#pragma unroll
    for (int o = 1; o < 64; o <<= 1) { const float t = __shfl_up(inc, o); if (F.lane >= o) inc += t; }
    if (F.lane == 63) wt[F.wave] = inc;
    __syncthreads();
    float base = inc - run;
    for (int w = 0; w < F.wave; ++w) base += wt[w];
#pragma unroll
    for (int j = 0; j < 16; ++j) CK[16 * F.tid + j] = base + v[j];
    __syncthreads();
}


namespace fa {
typedef short bf16x8 __attribute__((ext_vector_type(8)));
typedef short s16x4 __attribute__((ext_vector_type(4)));
typedef float f32x16 __attribute__((ext_vector_type(16)));
typedef float f32x4 __attribute__((ext_vector_type(4)));
typedef unsigned u32x4 __attribute__((ext_vector_type(4)));
constexpr int L_V = 0, L_K = 32768, L_KR = 65536, L_WS = 81920, L_BIAS = 83968, L_FLAG = 84480, L_ITEM = 84608;
constexpr int SHM = 16384;
#define FA_LP(T, off) ((LAS T*)(lds + (off)))
__device__ __forceinline__ int kswz(int row, int colB) { return row * 256 + (colB ^ ((row & 7) << 4)); }
__device__ __forceinline__ int krswz(int row, int colB) { return row * 128 + (colB ^ ((row & 7) << 4)); }
__device__ __forceinline__ int v_st(int k, int c) { const int kk = (k & ~0xC) | ((k & 4) << 1) | ((k & 8) >> 1); return ((kk >> 3) * 4 + (c >> 5)) * 512 + ((kk & 7) * 32 + (c & 31)) * 2; }
__device__ __forceinline__ int v_rd_base(int lane) { return ((lane & 3) << 3) | (((lane >> 2) & 3) << 6) | (((lane >> 4) & 1) << 5) | (((lane >> 5) & 1) << 8); }
constexpr int v_rd_off(int d0, int ks, int half) { return d0 * 512 + ks * 4096 + half * 2048; }
__device__ __forceinline__ int crow(int r, int hi) { return (r & 3) + 8 * (r >> 2) + 4 * hi; }
__device__ __forceinline__ unsigned cvtpk(float lo, float hi) { unsigned r; asm volatile("v_cvt_pk_bf16_f32 %0, %1, %2" : "=v"(r) : "v"(lo), "v"(hi)); return r; }
__device__ __forceinline__ float xsum(float v) { auto rr = __builtin_amdgcn_permlane32_swap(__float_as_uint(v), __float_as_uint(v), false, false); return __uint_as_float(rr[0]) + __uint_as_float(rr[1]); }
__device__ __forceinline__ float xmax(float v) { auto rr = __builtin_amdgcn_permlane32_swap(__float_as_uint(v), __float_as_uint(v), false, false); return fmaxf(__uint_as_float(rr[0]), __uint_as_float(rr[1])); }
#define FA_SBAR() __builtin_amdgcn_sched_barrier(0)

struct UnitRef {
    const bf16* Q; int qp;
    const bf16* K; int kp;
    const bf16* V; int vp;
    const bf16* KR;
    const float* CK;
    const float* COS; const float* SIN;
    bf16* O; int op;
    float* LSE; int lp;
    int P0;
    int jlo, jhi;
    float kn2;
};

template <int VAR>
__device__ __forceinline__ void attn_unit(LAS unsigned char* lds, const UnitRef& U, int tid) {
    constexpr int NQ = (VAR == 0) ? 12 : 8;
    constexpr float SCALE = (VAR == 0) ? 0.07216878364870323f : 0.08838834764831845f;
    constexpr float C2 = SCALE * 1.4426950408889634f;
    constexpr float THR2 = 8.f * 1.4426950408889634f;
    const int wid = __builtin_amdgcn_readfirstlane(tid >> 6), lane = tid & 63, r32 = lane & 31, hi = lane >> 5;
    const int W = (VAR == 1) ? 129 : 0x40000000;
    const int P0 = U.P0;
    const int j_lo = U.jlo, j_hi = U.jhi;
    const int qlo = P0 + wid * 32;
    const int qm = qlo + r32 - 4 * hi - (VAR == 2 ? 1 : 0);
    bf16x8 qr[NQ];
    { const bf16* qrow = U.Q + (size_t)(wid * 32 + r32) * U.qp + hi * 8;
#pragma unroll
      for (int d0 = 0; d0 < 8; ++d0) qr[d0] = *(const GAS bf16x8*)(qrow + d0 * 16);
      if constexpr (VAR == 0) {
          bf16x8 f[4];
#pragma unroll
          for (int d = 0; d < 4; ++d) f[d] = *(const GAS bf16x8*)(qrow + 128 + d * 16);
          const int pos = qlo + r32;
#pragma unroll
          for (int d = 0; d < 2; ++d) {
              const f32x4 c0 = *(const GAS f32x4*)(U.COS + (size_t)pos * 32 + d * 16 + hi * 8), c1 = *(const GAS f32x4*)(U.COS + (size_t)pos * 32 + d * 16 + hi * 8 + 4);
              const f32x4 s0 = *(const GAS f32x4*)(U.SIN + (size_t)pos * 32 + d * 16 + hi * 8), s1 = *(const GAS f32x4*)(U.SIN + (size_t)pos * 32 + d * 16 + hi * 8 + 4);
              float n1[8], n2[8];
#pragma unroll
              for (int j = 0; j < 8; ++j) { const float t1 = bf2f((unsigned short)f[d][j]), t2 = bf2f((unsigned short)f[d + 2][j]); const float c = j < 4 ? c0[j & 3] : c1[j & 3], s = j < 4 ? s0[j & 3] : s1[j & 3];
                  n1[j] = t1 * c - t2 * s; n2[j] = t1 * s + t2 * c; }
              u32x4 w1 = {pk2(n1[0], n1[1]), pk2(n1[2], n1[3]), pk2(n1[4], n1[5]), pk2(n1[6], n1[7])}, w2 = {pk2(n2[0], n2[1]), pk2(n2[2], n2[3]), pk2(n2[4], n2[5]), pk2(n2[6], n2[7])};
              qr[8 + d] = __builtin_bit_cast(bf16x8, w1); qr[10 + d] = __builtin_bit_cast(bf16x8, w2);
          }
      }
    }
    float qb2 = 0.f;
    if constexpr (VAR == 3) { float sq = 0.f;
#pragma unroll
        for (int d0 = 0; d0 < 8; ++d0)
#pragma unroll
            for (int j = 0; j < 8; ++j) { const float v = bf2f((unsigned short)qr[d0][j]); sq += v * v; }
        sq = xsum(sq); qb2 = sqrtf(sq * U.kn2) * C2; }
    unsigned dk, dv, dkr = 0;
    { const int krow = 4 * wid + (lane >> 4); dk = (unsigned)(krow * U.kp + (((lane & 15) ^ (krow & 7)) * 8)) * 2u;
      const int kk = ((wid >> 1) << 3) | ((lane & 31) >> 2); const int kv = (kk & ~0xC) | ((kk & 4) << 1) | ((kk & 8) >> 1); const int cv = (2 * (wid & 1) + (lane >> 5)) * 32 + (lane & 3) * 8;
      dv = (unsigned)(kv * U.vp + cv) * 2u;
      if constexpr (VAR == 0) { const int rr = 8 * wid + (lane >> 3); dkr = (unsigned)(rr * 64 + (((lane & 7) ^ (rr & 7)) * 8)) * 2u; } }
    float st_b = 0.f;
    float cref = 0.f; if constexpr (VAR == 3) cref = U.CK[P0];
#define FA_SLOAD(kb, bf) do { const char* kb_ = (const char*)(U.K + (size_t)(kb) * U.kp); const char* vb_ = (const char*)(U.V + (size_t)(kb) * U.vp); \
        __builtin_amdgcn_global_load_lds((const unsigned*)(kb_ + dk), FA_LP(unsigned, L_K + (bf) * SHM + wid * 1024), 16, 0, 0); \
        __builtin_amdgcn_global_load_lds((const unsigned*)(kb_ + (size_t)64 * U.kp + dk), FA_LP(unsigned, L_K + (bf) * SHM + 8192 + wid * 1024), 16, 0, 0); \
        __builtin_amdgcn_global_load_lds((const unsigned*)(vb_ + dv), FA_LP(unsigned, L_V + (bf) * SHM + wid * 1024), 16, 0, 0); \
        __builtin_amdgcn_global_load_lds((const unsigned*)(vb_ + (size_t)64 * U.vp + dv), FA_LP(unsigned, L_V + (bf) * SHM + 8192 + wid * 1024), 16, 0, 0); \
        if constexpr (VAR == 0) __builtin_amdgcn_global_load_lds((const unsigned*)((const char*)(U.KR + (size_t)(kb) * 64) + dkr), FA_LP(unsigned, L_KR + (bf) * 8192 + wid * 1024), 16, 0, 0); \
        if constexpr (VAR == 3) { st_b = U.CK[(kb) + lane]; } } while (0)
#define FA_SWRITE(bf) do { \
        if constexpr (VAR == 3) { if (tid < 64) *FA_LP(float, L_BIAS + (bf) * 256 + tid * 4) = (cref - st_b) * 1.4426950408889634f; } } while (0)
    LAS float* li_l = FA_LP(float, L_WS + wid * 256); LAS float* al_l = li_l + 32;
    const unsigned vb0 = (unsigned)(uintptr_t)(lds + L_V) + v_rd_base(lane);
    unsigned kb4[4];
#pragma unroll
    for (int dd = 0; dd < 4; ++dd) kb4[dd] = (unsigned)(uintptr_t)(lds + L_K) + kswz(r32, (dd * 16 + hi * 8) * 2);
    unsigned krb4[4];
    if constexpr (VAR == 0) {
#pragma unroll
        for (int dd = 0; dd < 4; ++dd) krb4[dd] = (unsigned)(uintptr_t)(lds + L_KR) + krswz(r32, (dd * 16 + hi * 8) * 2);
    }
    float m2 = -1e30f, l_reg = 0.f, R2 = 0.f;
    f32x16 o[4];
#pragma unroll
    for (int d = 0; d < 4; ++d)
#pragma unroll
        for (int r = 0; r < 16; ++r) o[d][r] = 0.f;
    bool wdone = false;
    FA_SLOAD((j_hi - 1) * 64, 0);
    asm volatile("s_waitcnt vmcnt(0)" ::: "memory");
    FA_SWRITE(0);
    __syncthreads();

#define FA_TRRD(dst, off) asm volatile("ds_read_b64_tr_b16 %0, %1 offset:%2" : "=&v"(dst) : "v"(vb0), "i"(off) : "memory")
#define FA_VRD8(S, BUF, d0) do { constexpr int b_ = (BUF) * SHM + v_rd_off(d0, 0, 0); \
        FA_TRRD(S##l0, b_); FA_TRRD(S##h0, b_ + 2048); FA_TRRD(S##l1, b_ + 4096); FA_TRRD(S##h1, b_ + 6144); FA_TRRD(S##l2, b_ + 8192); FA_TRRD(S##h2, b_ + 10240); FA_TRRD(S##l3, b_ + 12288); FA_TRRD(S##h3, b_ + 14336); } while (0)
#define FA_PVMMA(S, d0) do { \
        o[d0] = __builtin_amdgcn_mfma_f32_32x32x16_bf16(pa0, (bf16x8){S##l0[0], S##l0[1], S##l0[2], S##l0[3], S##h0[0], S##h0[1], S##h0[2], S##h0[3]}, o[d0], 0, 0, 0); \
        o[d0] = __builtin_amdgcn_mfma_f32_32x32x16_bf16(pa1, (bf16x8){S##l1[0], S##l1[1], S##l1[2], S##l1[3], S##h1[0], S##h1[1], S##h1[2], S##h1[3]}, o[d0], 0, 0, 0); \
        o[d0] = __builtin_amdgcn_mfma_f32_32x32x16_bf16(pa2, (bf16x8){S##l2[0], S##l2[1], S##l2[2], S##l2[3], S##h2[0], S##h2[1], S##h2[2], S##h2[3]}, o[d0], 0, 0, 0); \
        o[d0] = __builtin_amdgcn_mfma_f32_32x32x16_bf16(pa3, (bf16x8){S##l3[0], S##l3[1], S##l3[2], S##l3[3], S##h3[0], S##h3[1], S##h3[2], S##h3[3]}, o[d0], 0, 0, 0); } while (0)
#define FA_LGKM(n) asm volatile("s_waitcnt lgkmcnt(" #n ")" ::: "memory")
#define FA_PV(BUF) do { s16x4 Xl0, Xl1, Xl2, Xl3, Xh0, Xh1, Xh2, Xh3, Yl0, Yl1, Yl2, Yl3, Yh0, Yh1, Yh2, Yh3; \
        FA_VRD8(X, BUF, 0); FA_VRD8(Y, BUF, 1); FA_LGKM(8); FA_SBAR(); FA_PVMMA(X, 0); FA_SBAR(); \
        FA_VRD8(X, BUF, 2); FA_LGKM(8); FA_SBAR(); FA_PVMMA(Y, 1); FA_SBAR(); \
        FA_VRD8(Y, BUF, 3); FA_LGKM(8); FA_SBAR(); FA_PVMMA(X, 2); FA_SBAR(); \
        FA_LGKM(0); FA_SBAR(); FA_PVMMA(Y, 3); } while (0)
#define FA_VRD4(S, BUF, d0, ks) do { constexpr int b_ = (BUF) * SHM + v_rd_off(d0, ks, 0); FA_TRRD(S##l0, b_); FA_TRRD(S##h0, b_ + 2048); FA_TRRD(S##l1, b_ + 4096); FA_TRRD(S##h1, b_ + 6144); } while (0)
#define FA_MMA2(S, d0, PA, PB) do { \
        o[d0] = __builtin_amdgcn_mfma_f32_32x32x16_bf16(PA, (bf16x8){S##l0[0], S##l0[1], S##l0[2], S##l0[3], S##h0[0], S##h0[1], S##h0[2], S##h0[3]}, o[d0], 0, 0, 0); \
        o[d0] = __builtin_amdgcn_mfma_f32_32x32x16_bf16(PB, (bf16x8){S##l1[0], S##l1[1], S##l1[2], S##l1[3], S##h1[0], S##h1[1], S##h1[2], S##h1[3]}, o[d0], 0, 0, 0); } while (0)
#define FA_EXPS(P, i0) do { _Pragma("unroll") for (int r_ = (i0); r_ < (i0) + 4; ++r_) { if constexpr (VAR == 3) P[r_] = __builtin_amdgcn_exp2f(P[r_] - m2); else P[r_] = __builtin_amdgcn_exp2f(fmaf(P[r_], C2, -m2)); ps += P[r_]; } } while (0)
#define FA_PV2(BUF) do { s16x4 Al0, Ah0, Al1, Ah1, Bl0, Bh0, Bl1, Bh1, Cl0, Ch0, Cl1, Ch1, Dl0, Dh0, Dl1, Dh1; \
        FA_VRD4(A, BUF, 0, 0); FA_VRD4(B, BUF, 1, 0); FA_VRD4(C, BUF, 2, 0); FA_VRD4(D, BUF, 3, 0); \
        FA_LGKM(12); FA_SBAR(); FA_MMA2(A, 0, pa0, pa1); FA_SBAR(); FA_EXPS(p1, 0); FA_VRD4(A, BUF, 0, 2); \
        FA_LGKM(12); FA_SBAR(); FA_MMA2(B, 1, pa0, pa1); FA_SBAR(); FA_EXPS(p1, 4); FA_PK4(p1, 0, pa2); FA_VRD4(B, BUF, 1, 2); \
        FA_LGKM(12); FA_SBAR(); FA_MMA2(C, 2, pa0, pa1); FA_SBAR(); FA_EXPS(p1, 8); FA_VRD4(C, BUF, 2, 2); \
        FA_LGKM(12); FA_SBAR(); FA_MMA2(D, 3, pa0, pa1); FA_SBAR(); FA_EXPS(p1, 12); FA_PK4(p1, 8, pa3); FA_VRD4(D, BUF, 3, 2); \
        FA_LGKM(12); FA_SBAR(); FA_MMA2(A, 0, pa2, pa3); FA_SBAR(); \
        FA_LGKM(8); FA_SBAR(); FA_MMA2(B, 1, pa2, pa3); FA_SBAR(); \
        FA_LGKM(4); FA_SBAR(); FA_MMA2(C, 2, pa2, pa3); FA_SBAR(); \
        FA_LGKM(0); FA_SBAR(); FA_MMA2(D, 3, pa2, pa3); } while (0)
#define FA_KRD(dst, areg, off) asm volatile("ds_read_b128 %0, %1 offset:%2" : "=&v"(dst) : "v"(areg), "i"(off) : "memory")
#define FA_KPAIR(A_, B_, BUF, d0) do { if constexpr ((d0) < 8) { FA_KRD(A_, kb4[(d0) & 3], ((d0) >> 2) * 128 + (BUF) * SHM); FA_KRD(B_, kb4[(d0) & 3], ((d0) >> 2) * 128 + (BUF) * SHM + 32 * 256); } \
        else { FA_KRD(A_, krb4[((d0) - 8) & 3], (BUF) * 8192); FA_KRD(B_, krb4[((d0) - 8) & 3], (BUF) * 8192 + 32 * 128); } } while (0)
#define FA_QKMMA(A_, B_, d0) do { p0 = __builtin_amdgcn_mfma_f32_32x32x16_bf16(A_, qr[d0], p0, 0, 0, 0); p1 = __builtin_amdgcn_mfma_f32_32x32x16_bf16(B_, qr[d0], p1, 0, 0, 0); } while (0)
#define FA_QKSTEP(CA, CB, NA, NB, BUF, d0) do { if constexpr ((d0) + 1 < NQ) { FA_KPAIR(NA, NB, BUF, (d0) + 1); FA_LGKM(2); } else { FA_LGKM(0); } FA_SBAR(); FA_QKMMA(CA, CB, d0); FA_SBAR(); } while (0)
#define FA_QK(BUF) do { bf16x8 ea, eb, fa_, fb; FA_KPAIR(ea, eb, BUF, 0); \
        FA_QKSTEP(ea, eb, fa_, fb, BUF, 0); FA_QKSTEP(fa_, fb, ea, eb, BUF, 1); FA_QKSTEP(ea, eb, fa_, fb, BUF, 2); FA_QKSTEP(fa_, fb, ea, eb, BUF, 3); \
        FA_QKSTEP(ea, eb, fa_, fb, BUF, 4); FA_QKSTEP(fa_, fb, ea, eb, BUF, 5); FA_QKSTEP(ea, eb, fa_, fb, BUF, 6); FA_QKSTEP(fa_, fb, ea, eb, BUF, 7); \
        if constexpr (NQ == 12) { FA_QKSTEP(ea, eb, fa_, fb, BUF, 8); FA_QKSTEP(fa_, fb, ea, eb, BUF, 9); FA_QKSTEP(ea, eb, fa_, fb, BUF, 10); FA_QKSTEP(fa_, fb, ea, eb, BUF, 11); } } while (0)
#define FA_PK4(P, B_, OUT) do { unsigned a0 = cvtpk(P[B_ + 0], P[B_ + 1]), a1 = cvtpk(P[B_ + 2], P[B_ + 3]); unsigned b0 = cvtpk(P[B_ + 4], P[B_ + 5]), b1 = cvtpk(P[B_ + 6], P[B_ + 7]); \
        auto r0 = __builtin_amdgcn_permlane32_swap(a0, b0, false, false); auto r1 = __builtin_amdgcn_permlane32_swap(a1, b1, false, false); \
        u32x4 w = {r0[0], r1[0], r0[1], r1[1]}; OUT = __builtin_bit_cast(bf16x8, w); } while (0)

#define FA_STEP(BUF, jt) do { \
        const int kb = (jt) * 64; const bool more = (jt) > j_lo; \
        if (more) FA_SLOAD(kb - 64, (BUF) ^ 1); \
        const bool act = !wdone && (kb <= qlo + 31) && (kb + 63 >= qlo - W + 1); \
        if (act) { \
            f32x16 p0, p1; \
            _Pragma("unroll") for (int r = 0; r < 16; ++r) { p0[r] = 0.f; p1[r] = 0.f; } \
            FA_QK(BUF); \
            bf16x8 pa0, pa1, pa2, pa3; \
            const int dq = qm - kb; \
            const bool needmask = (kb + 63 >= qlo) || (kb <= qlo + 31 - W); \
            if constexpr (VAR == 2) { \
                  \
                _Pragma("unroll") for (int r = 0; r < 16; ++r) { p0[r] = fminf(p0[r] * C2, 100.f); p1[r] = fminf(p1[r] * C2, 100.f); } \
                f32x16 x0, x1; \
                _Pragma("unroll") for (int r = 0; r < 16; ++r) { x0[r] = __builtin_amdgcn_logf(1.f + __builtin_amdgcn_exp2f(p0[r])); x1[r] = __builtin_amdgcn_logf(1.f + __builtin_amdgcn_exp2f(p1[r])); } \
                if (needmask) { _Pragma("unroll") for (int r = 0; r < 16; ++r) { const int c = (r & 3) + 8 * (r >> 2); \
                    if (dq - c < 0) { x0[r] = 0.f; p0[r] = -__builtin_inff(); } if (dq - c - 32 < 0) { x1[r] = 0.f; p1[r] = -__builtin_inff(); } } } \
                float S0[4], S1[4], C0[4], C1[4]; \
                _Pragma("unroll") for (int i = 0; i < 4; ++i) { S0[i] = (x0[4 * i] + x0[4 * i + 1]) + (x0[4 * i + 2] + x0[4 * i + 3]); S1[i] = (x1[4 * i] + x1[4 * i + 1]) + (x1[4 * i + 2] + x1[4 * i + 3]); \
                    C0[i] = xsum(S0[i]); C1[i] = xsum(S1[i]); } \
                const float fsel = hi ? 0.f : 1.f; \
                float E1[4], E0[4]; E1[3] = 0.f; E1[2] = C1[3]; E1[1] = E1[2] + C1[2]; E1[0] = E1[1] + C1[1]; const float T1 = E1[0] + C1[0]; \
                E0[3] = 0.f; E0[2] = C0[3]; E0[1] = E0[2] + C0[2]; E0[0] = E0[1] + C0[1]; const float T0 = E0[0] + C0[0]; \
                _Pragma("unroll") for (int i = 0; i < 4; ++i) { \
                    float ag = R2 + E1[i] + fsel * (C1[i] - S1[i]); \
                    float a3 = ag, a2 = a3 + x1[4 * i + 3], a1 = a2 + x1[4 * i + 2], a0 = a1 + x1[4 * i + 1]; \
                    p1[4 * i + 3] = __builtin_amdgcn_exp2f(p1[4 * i + 3] - x1[4 * i + 3] - a3); p1[4 * i + 2] = __builtin_amdgcn_exp2f(p1[4 * i + 2] - x1[4 * i + 2] - a2); \
                    p1[4 * i + 1] = __builtin_amdgcn_exp2f(p1[4 * i + 1] - x1[4 * i + 1] - a1); p1[4 * i + 0] = __builtin_amdgcn_exp2f(p1[4 * i + 0] - x1[4 * i + 0] - a0); \
                    ag = R2 + T1 + E0[i] + fsel * (C0[i] - S0[i]); \
                    a3 = ag; a2 = a3 + x0[4 * i + 3]; a1 = a2 + x0[4 * i + 2]; a0 = a1 + x0[4 * i + 1]; \
                    p0[4 * i + 3] = __builtin_amdgcn_exp2f(p0[4 * i + 3] - x0[4 * i + 3] - a3); p0[4 * i + 2] = __builtin_amdgcn_exp2f(p0[4 * i + 2] - x0[4 * i + 2] - a2); \
                    p0[4 * i + 1] = __builtin_amdgcn_exp2f(p0[4 * i + 1] - x0[4 * i + 1] - a1); p0[4 * i + 0] = __builtin_amdgcn_exp2f(p0[4 * i + 0] - x0[4 * i + 0] - a0); } \
                R2 += T0 + T1; \
                FA_PK4(p0, 0, pa0); FA_PK4(p0, 8, pa1); FA_PK4(p1, 0, pa2); FA_PK4(p1, 8, pa3); \
            } else { \
                if constexpr (VAR == 3) { \
                    _Pragma("unroll") for (int g = 0; g < 4; ++g) { const f32x4 b0 = *FA_LP(f32x4, L_BIAS + (BUF) * 256 + (8 * g + 4 * hi) * 4), b1 = *FA_LP(f32x4, L_BIAS + (BUF) * 256 + (32 + 8 * g + 4 * hi) * 4); \
                        _Pragma("unroll") for (int e = 0; e < 4; ++e) { p0[4 * g + e] = fmaf(p0[4 * g + e], C2, b0[e]); p1[4 * g + e] = fmaf(p1[4 * g + e], C2, b1[e]); } } \
                } \
                if (needmask) { _Pragma("unroll") for (int r = 0; r < 16; ++r) { const int c = (r & 3) + 8 * (r >> 2); \
                    if ((unsigned)(dq - c) >= (unsigned)W) p0[r] = -__builtin_inff(); if ((unsigned)(dq - c - 32) >= (unsigned)W) p1[r] = -__builtin_inff(); } } \
                float pmax = p0[0]; \
                _Pragma("unroll") for (int r = 1; r < 16; ++r) pmax = fmaxf(pmax, p0[r]); \
                _Pragma("unroll") for (int r = 0; r < 16; ++r) pmax = fmaxf(pmax, p1[r]); \
                pmax = xmax(pmax); if constexpr (VAR != 3) pmax *= C2;     \
                float alpha = 1.f; \
                if (!__all(pmax - m2 <= THR2)) { const float mn = fmaxf(m2, pmax); alpha = __builtin_amdgcn_exp2f(m2 - mn); m2 = mn; } \
                float ps = 0.f; \
                FA_EXPS(p0, 0); FA_EXPS(p0, 4); FA_EXPS(p0, 8); FA_EXPS(p0, 12);     \
                if (__any(alpha < 1.f)) { if (hi == 0) al_l[r32] = alpha; asm volatile("s_waitcnt lgkmcnt(0)" ::: "memory"); \
                    _Pragma("unroll") for (int r = 0; r < 16; ++r) { const float a_ = al_l[crow(r, hi)]; o[0][r] *= a_; o[1][r] *= a_; o[2][r] *= a_; o[3][r] *= a_; } } \
                FA_PK4(p0, 0, pa0); FA_PK4(p0, 8, pa1); \
                FA_SBAR(); FA_PV2(BUF); \
                ps = xsum(ps); l_reg = l_reg * alpha + ps; \
            } \
            if constexpr (VAR == 2) { FA_SBAR(); FA_PV(BUF); } \
        } \
        if (more) { asm volatile("s_waitcnt vmcnt(0)" ::: "memory"); FA_SWRITE((BUF) ^ 1); } \
        if constexpr (VAR == 2) wdone = wdone || __all(R2 > 64.f); \
        if constexpr (VAR == 3) { if (more) { const float bnext = (cref - __builtin_bit_cast(float, __builtin_amdgcn_readlane(__builtin_bit_cast(int, st_b), 63))) * 1.4426950408889634f; wdone = wdone || __all(qb2 + bnext - m2 < -40.f); } } \
        if constexpr (VAR == 2 || VAR == 3) { if (lane == 0) *FA_LP(int, L_FLAG + (BUF) * 32 + wid * 4) = wdone ? 1 : 0; } \
        asm volatile("s_waitcnt lgkmcnt(0)" ::: "memory"); __builtin_amdgcn_s_barrier(); asm volatile("" ::: "memory");     \
        if constexpr (VAR == 2 || VAR == 3) { int nd = 0; _Pragma("unroll") for (int w_ = 0; w_ < 8; ++w_) nd += *FA_LP(int, L_FLAG + (BUF) * 32 + w_ * 4); if (nd == 8) goto fa_done; } \
    } while (0)

    for (int jt = j_hi - 1; jt >= j_lo; jt -= 2) {
        FA_STEP(0, jt);
        if (jt - 1 < j_lo) break;
        FA_STEP(1, jt - 1);
    }
fa_done:
    {
        const int tid2 = opaque(tid); const int r32 = tid2 & 31, hi = (tid2 >> 5) & 1;
        float rli[16];
        if constexpr (VAR != 2) {
            if (hi == 0) li_l[r32] = l_reg; asm volatile("s_waitcnt lgkmcnt(0)" ::: "memory");
#pragma unroll
            for (int r = 0; r < 16; ++r) rli[r] = __builtin_amdgcn_rcpf(li_l[crow(r, hi)]);
        } else {
#pragma unroll
            for (int r = 0; r < 16; ++r) rli[r] = 1.f;
        }
        bf16* Ow = U.O + (size_t)(wid * 32) * U.op;
        { const bool odd = (r32 & 1) != 0, up2 = (r32 & 2) != 0;
#define FA_X1(x) __builtin_bit_cast(float, __builtin_amdgcn_mov_dpp(__builtin_bit_cast(int, (x)), 0xB1, 0xF, 0xF, true))
#define FA_X2(x) ((unsigned)__builtin_amdgcn_mov_dpp((int)(x), 0x4E, 0xF, 0xF, true))
#pragma unroll
          for (int rg = 0; rg < 4; ++rg) { const int r0 = 4 * rg; bf16* rowp = Ow + (size_t)(8 * rg + 4 * hi + (r32 & 3)) * U.op + (r32 & ~3);
#pragma unroll
            for (int d0 = 0; d0 < 4; ++d0) {
                const float v0 = o[d0][r0] * rli[r0], v1 = o[d0][r0 + 1] * rli[r0 + 1], v2 = o[d0][r0 + 2] * rli[r0 + 2], v3 = o[d0][r0 + 3] * rli[r0 + 3];
                const float n0 = FA_X1(v0), n1 = FA_X1(v1), n2 = FA_X1(v2), n3 = FA_X1(v3);
                const unsigned wa = cvtpk(odd ? n1 : v0, odd ? v1 : n0), wb = cvtpk(odd ? n3 : v2, odd ? v3 : n2);
                const unsigned got = FA_X2(up2 ? wa : wb);
                const unsigned long long w8 = up2 ? ((unsigned long long)got | ((unsigned long long)wb << 32)) : ((unsigned long long)wa | ((unsigned long long)got << 32));
                *(GAS unsigned long long*)(rowp + d0 * 32) = w8; } }
#undef FA_X1
#undef FA_X2
        }
        if constexpr (VAR != 2) { if (U.LSE != nullptr && hi == 0) U.LSE[(size_t)(wid * 32 + r32) * U.lp] = (m2 + __builtin_amdgcn_logf(l_reg)) * 0.6931471805599453f; }
    }
    __syncthreads();
#undef FA_SLOAD
#undef FA_SWRITE
#undef FA_TRRD
#undef FA_VRD8
#undef FA_PVMMA
#undef FA_LGKM
#undef FA_PV
#undef FA_PV2
#undef FA_VRD4
#undef FA_MMA2
#undef FA_EXPS
#undef FA_KRD
#undef FA_KPAIR
#undef FA_QKMMA
#undef FA_QKSTEP
#undef FA_QK
#undef FA_PK4
#undef FA_STEP
}
}


#ifndef FASTMASK
#define FASTMASK 15
#endif
__device__ __forceinline__ void fast_attn_phase(Frame& F, const Ptrs& P, int l, int vmask = 15) {
    LAS unsigned char* lds = F.lds + RING_OFF;
    LAS int* itemw = (LAS int*)(lds + fa::L_ITEM);
    gu32* qhead = F.ctl + CW_QUEUE + 64 * l;
    bf16* PROJ = wsb(P, WS_PROJ); bf16* O = wsb(P, WS_O);
    constexpr int N_A = 384, N_D = 256, N_C = 256, N_B = 768, N_REST = N_D + N_C + N_B;
    constexpr int CV_IN = (DM / 64) * (NP / 64) + (QLR / 64) * (NQA / 64) + 2 * (KVLR / 64) * (GW / 64), CV_GRP = (DM / 64) * (DM / 64) + (DM / 64) * (DFF / 64) + (DFF / 64) * (DM / 64), CH = 64;
    constexpr int NC_GRP = (CV_GRP + CH - 1) / CH, NC_IN = (CV_IN + CH - 1) / CH;
    const int n_conv = (vmask == 15) ? NC_GRP + ((l == 0) ? NC_IN : 0) : 0;
    const int n_pair = (n_conv < N_A + N_REST) ? n_conv : N_A + N_REST;
    const int N_ITEMS = N_A + N_REST + n_conv;
    for (;;) {
        if (F.tid == 0) *itemw = (int)__hip_atomic_fetch_add(qhead, 1u, __ATOMIC_RELAXED, __HIP_MEMORY_SCOPE_AGENT);
        __syncthreads();
        int item = __builtin_amdgcn_readfirstlane(*itemw);
        __syncthreads();
        if (item >= N_ITEMS) break;
        {
            const int j = item; int cv = -1, un;
            if (j < 2 * n_pair) { if (j & 1) cv = j >> 1; else un = j >> 1; } else { const int t = j - 2 * n_pair; if (n_conv > N_A + N_REST) cv = n_pair + t; else un = n_pair + t; }
            if (cv >= 0) {
                if (cv < NC_GRP) { const int lo_ = CV_IN + cv * CH; conv_range(F, P, l, lo_, (lo_ + CH < CV_IN + CV_GRP) ? lo_ + CH : CV_IN + CV_GRP); }
                else { const int lo_ = (cv - NC_GRP) * CH; conv_range(F, P, 1, lo_, (lo_ + CH < CV_IN) ? lo_ + CH : CV_IN); }
                continue; }
            item = un;
        }
        fa::UnitRef U; U.KR = nullptr; U.CK = nullptr; U.COS = nullptr; U.SIN = nullptr; U.LSE = nullptr; U.lp = 0; U.kn2 = 0.f;
        if (item < N_A) {
            if (!(FASTMASK & 1) || !(vmask & 1)) continue;
            const int a = item >> 3, h = item & 7, k = a / 3, j = a - 3 * k;
            const int qb = (j < 2) ? 31 - k : 15 - k;
            U.Q = wsb(P, WS_QA) + (size_t)(qb * 256) * NQA + h * 192; U.qp = NQA; U.K = wsb(P, WS_KVU) + h * HD; U.kp = NKVU; U.V = wsb(P, WS_KVU) + GW + h * HD; U.vp = NKVU;
            U.KR = wsb(P, WS_KR); U.COS = wsf(P, WS_COS64); U.SIN = wsf(P, WS_SIN64); U.P0 = qb * 256;
            if (j < 2) { U.jlo = j * 2 * (qb + 1); U.jhi = (j + 1) * 2 * (qb + 1);
                U.O = wsb(P, WS_PA) + (size_t)j * S * GW + (size_t)(qb * 256) * GW + h * HD; U.op = GW; U.LSE = wsf(P, WS_LSEA) + (size_t)j * S * NH + (size_t)(qb * 256) * NH + h; U.lp = NH; }
            else { U.jlo = 0; U.jhi = 4 * (qb + 1); U.O = O + (size_t)(qb * 256) * DM + h * HD; U.op = DM; }
            fa::attn_unit<0>(lds, U, opaque(F.tid));
        } else if (item < N_A + N_D) {
            if (!(FASTMASK & 8) || !(vmask & 8)) continue;
            const int i = item - N_A, qb = 31 - (i >> 3), h = i & 7;
            U.Q = PROJ + (size_t)(qb * 256) * NP + PC_D + h * HD; U.qp = NP; U.K = PROJ + PC_D + GW + h * HD; U.kp = NP; U.V = PROJ + PC_D + 2 * GW + h * HD; U.vp = NP;
            U.CK = wsf(P, WS_CK) + (size_t)h * S; U.O = O + (size_t)(qb * 256) * DM + 3 * GW + h * HD; U.op = DM; U.P0 = qb * 256; U.jlo = 0; U.jhi = 4 * (qb + 1);
            U.kn2 = __builtin_bit_cast(float, __hip_atomic_load(F.ctl + CW_KN + 16 * (l & 1) + h, __ATOMIC_RELAXED, __HIP_MEMORY_SCOPE_AGENT));
            fa::attn_unit<3>(lds, U, opaque(F.tid));
        } else if (item < N_A + N_D + N_C) {
            if (!(FASTMASK & 4) || !(vmask & 4)) continue;
            const int i = item - N_A - N_D, qb = 31 - (i >> 3), h = i & 7;
            U.Q = PROJ + (size_t)(qb * 256) * NP + PC_C + h * HD; U.qp = NP; U.K = PROJ + PC_C + GW + h * HD; U.kp = NP; U.V = PROJ + PC_C + 2 * GW + h * HD; U.vp = NP;
            U.O = O + (size_t)(qb * 256) * DM + 2 * GW + h * HD; U.op = DM; U.P0 = qb * 256; U.jlo = 0; U.jhi = 4 * (qb + 1);
            fa::attn_unit<2>(lds, U, opaque(F.tid));
        } else {
            if (!(FASTMASK & 2) || !(vmask & 2)) continue;
            const int i = item - N_A - N_D - N_C, br = i >> 8, rest = i & 255, h = rest & 7, blk = rest >> 3;
            const int dil = (br == 0) ? 1 : (br == 1) ? 4 : 16; const int nbr = (S / dil) / 256; const int res = blk / nbr, bi = blk - res * nbr;
            const size_t tok0 = (size_t)res + (size_t)dil * (bi * 256);
            U.Q = PROJ + tok0 * NP + PC_B + h * HD; U.qp = dil * NP; U.K = PROJ + (size_t)res * NP + PC_B + GW + h * HD; U.kp = dil * NP; U.V = PROJ + (size_t)res * NP + PC_B + 2 * GW + h * HD; U.vp = dil * NP;
            U.O = wsb(P, WS_OB) + (size_t)br * S * GW + tok0 * GW + h * HD; U.op = dil * GW; U.LSE = wsf(P, WS_LSE) + (size_t)br * S * NH + tok0 * NH + h; U.lp = dil * NH; U.P0 = bi * 256;
            U.jlo = (bi * 256 - 128 > 0) ? (bi * 256 - 128) / 64 : 0; U.jhi = 4 * (bi + 1);
            fa::attn_unit<1>(lds, U, opaque(F.tid));
        }
    }
}

__device__ __forceinline__ void slow_attn_task(const Ptrs& P, int var, int h, int t, int lane) {
    const bf16* PROJ = wsb(P, WS_PROJ); bf16* O = wsb(P, WS_O);
    const bf16 *qp, *kbase, *vbase; int kp;
    float scale = 0.08838834764831845f;
    float qr_ = 0.f;
    const bf16* krb = wsb(P, WS_KR);
    if (var == 0) { qp = wsb(P, WS_QA) + (size_t)t * NQA + h * 192; kbase = wsb(P, WS_KVU) + h * HD; vbase = wsb(P, WS_KVU) + GW + h * HD; kp = NKVU; scale = 0.07216878364870323f;
        const float mine = bf2f(qp[128 + lane]); const float other = __shfl_xor(mine, 32);
        const float c = wsf(P, WS_COS64)[t * 32 + (lane & 31)], sn = wsf(P, WS_SIN64)[t * 32 + (lane & 31)];
        qr_ = (lane < 32) ? (mine * c - other * sn) : (other * sn + mine * c);
        qr_ = bf2f((bf16)f2bf(qr_)); }
    else { const int pc = (var == 1) ? PC_B : (var == 2) ? PC_C : PC_D; qp = PROJ + (size_t)t * NP + pc + h * HD; kbase = PROJ + pc + GW + h * HD; vbase = PROJ + pc + 2 * GW + h * HD; kp = NP; }
    const unsigned qw = *(const GAS unsigned*)(qp + 2 * lane); const float q0 = bflo(qw), q1 = bfhi(qw);
    float o0 = 0.f, o1 = 0.f;
    if (var == 2) {
        float R = 0.f;
        for (int s0 = t - 1; s0 >= 0; s0 -= 4) {
            float part[4]; unsigned vw[4];
#pragma unroll
            for (int i = 0; i < 4; ++i) { const int s = s0 - i; const int sc = s < 0 ? 0 : s; const unsigned kw = *(const GAS unsigned*)(kbase + (size_t)sc * kp + 2 * lane); vw[i] = *(const GAS unsigned*)(vbase + (size_t)sc * kp + 2 * lane);
                part[i] = q0 * bflo(kw) + q1 * bfhi(kw); }
#pragma unroll
            for (int i = 0; i < 4; ++i) part[i] = wave_sum(part[i]);
#pragma unroll
            for (int i = 0; i < 4; ++i) { if (s0 - i >= 0) { const float z = part[i] * scale; const float sp = fmaxf(z, 0.f) + log1pf(expf(-fabsf(z))); const float a = expf(z - sp - R); R += sp; o0 += a * bflo(vw[i]); o1 += a * bfhi(vw[i]); } }
            if (R > 100.f) break;
        }
    } else {
        float m = -1e30f, lsum = 0.f;
        const float* CK = wsf(P, WS_CK) + (size_t)h * S; const float cq = (var == 3) ? CK[t] : 0.f;
        const int nbr = (var == 1) ? 3 : 1;
        for (int br = 0; br < nbr; ++br) {
            const int dil = (var == 1) ? (br == 0 ? 1 : br == 1 ? 4 : 16) : 1; const int nk = (var == 1) ? 129 : t + 1;
            for (int j0 = 0; j0 < nk; j0 += 4) {
                float part[4]; unsigned vw[4]; float bias[4]; bool ok[4];
#pragma unroll
                for (int i = 0; i < 4; ++i) { const int j = j0 + i; const int s = t - dil * j; ok[i] = (j < nk) && (s >= 0); const int sc = ok[i] ? s : 0;
                    const unsigned kw = *(const GAS unsigned*)(kbase + (size_t)sc * kp + 2 * lane); vw[i] = *(const GAS unsigned*)(vbase + (size_t)sc * kp + 2 * lane);
                    part[i] = q0 * bflo(kw) + q1 * bfhi(kw);
                    if (var == 0) part[i] += qr_ * bf2f(krb[(size_t)sc * 64 + lane]);
                    bias[i] = (var == 3) ? (cq - CK[sc]) : 0.f; }
#pragma unroll
                for (int i = 0; i < 4; ++i) part[i] = wave_sum(part[i]);
                float sc4[4]; float mx = m;
#pragma unroll
                for (int i = 0; i < 4; ++i) { sc4[i] = ok[i] ? part[i] * scale + bias[i] : -__builtin_inff(); mx = fmaxf(mx, sc4[i]); }
                const float alpha = expf(m - mx); lsum *= alpha; o0 *= alpha; o1 *= alpha; m = mx;
#pragma unroll
                for (int i = 0; i < 4; ++i) { const float p = expf(sc4[i] - mx); lsum += p; o0 += p * bflo(vw[i]); o1 += p * bfhi(vw[i]); }
            }
        }
        o0 /= lsum; o1 /= lsum;
    }
    *(GAS unsigned*)(O + (size_t)t * DM + var * GW + h * HD + 2 * lane) = pk2(o0, o1);
}
__device__ __forceinline__ void slow_attn_phase(Frame& F, const Ptrs& P) {
    const int gw = blockIdx.x * NWAVES + F.wave, NGW = F.G * NWAVES;
    for (int k = 0; (size_t)k * NGW + gw < (size_t)S * 32; ++k) {
        const int n = k * NGW + gw; const int t = n >> 5; const int hv = (gw + k) & 31;
        if ((FASTMASK >> (hv & 3)) & 1) continue;
        slow_attn_task(P, hv & 3, hv >> 2, t, F.lane);
    }
}

__device__ __forceinline__ void groupnorm_rows(Frame& F, const Ptrs& P, int l) {
    const int gw = blockIdx.x * NWAVES + F.wave, NGW = F.G * NWAVES, lane = F.lane;
    const bf16* O = wsb(P, WS_O); bf16* ON = wsb(P, WS_H); const float* go = P.g_out + (size_t)l * DM;
    for (int m = gw; m < S; m += NGW) {
#pragma unroll
        for (int g = 0; g < 4; ++g) {
            float f[16]; float s = 0.f;
#pragma unroll
            for (int c = 0; c < 2; ++c) {
                if ((FASTMASK & 2) && g == 1) {
                    const int hh = c * 4 + (lane >> 4); const float* L = wsf(P, WS_LSE) + (size_t)m * NH + hh;
                    const float l0 = L[0], l1 = L[(size_t)S * NH], l2 = L[(size_t)2 * S * NH]; const float mx = fmaxf(l0, fmaxf(l1, l2));
                    float w0 = expf(l0 - mx), w1 = expf(l1 - mx), w2 = expf(l2 - mx); const float inv = 1.f / (w0 + w1 + w2); w0 *= inv; w1 *= inv; w2 *= inv;
                    const bf16* ob = wsb(P, WS_OB) + (size_t)m * GW + c * 512 + 8 * lane;
                    const v4u a = *(const GAS v4u*)ob, b = *(const GAS v4u*)(ob + (size_t)S * GW), d = *(const GAS v4u*)(ob + (size_t)2 * S * GW);
                    f[8 * c + 0] = w0 * bflo(a.x) + w1 * bflo(b.x) + w2 * bflo(d.x); f[8 * c + 1] = w0 * bfhi(a.x) + w1 * bfhi(b.x) + w2 * bfhi(d.x);
                    f[8 * c + 2] = w0 * bflo(a.y) + w1 * bflo(b.y) + w2 * bflo(d.y); f[8 * c + 3] = w0 * bfhi(a.y) + w1 * bfhi(b.y) + w2 * bfhi(d.y);
                    f[8 * c + 4] = w0 * bflo(a.z) + w1 * bflo(b.z) + w2 * bflo(d.z); f[8 * c + 5] = w0 * bfhi(a.z) + w1 * bfhi(b.z) + w2 * bfhi(d.z);
                    f[8 * c + 6] = w0 * bflo(a.w) + w1 * bflo(b.w) + w2 * bflo(d.w); f[8 * c + 7] = w0 * bfhi(a.w) + w1 * bfhi(b.w) + w2 * bfhi(d.w);
                    continue; }
                if ((FASTMASK & 1) && g == 0 && m >= S / 2) {
                    const int hh = c * 4 + (lane >> 4); const float* L = wsf(P, WS_LSEA) + (size_t)m * NH + hh;
                    const float l0 = L[0], l1 = L[(size_t)S * NH]; const float mx = fmaxf(l0, l1);
                    float w0 = expf(l0 - mx), w1 = expf(l1 - mx); const float inv = 1.f / (w0 + w1); w0 *= inv; w1 *= inv;
                    const bf16* ob = wsb(P, WS_PA) + (size_t)m * GW + c * 512 + 8 * lane;
                    const v4u a = *(const GAS v4u*)ob, b = *(const GAS v4u*)(ob + (size_t)S * GW);
                    f[8 * c + 0] = w0 * bflo(a.x) + w1 * bflo(b.x); f[8 * c + 1] = w0 * bfhi(a.x) + w1 * bfhi(b.x); f[8 * c + 2] = w0 * bflo(a.y) + w1 * bflo(b.y); f[8 * c + 3] = w0 * bfhi(a.y) + w1 * bfhi(b.y);
                    f[8 * c + 4] = w0 * bflo(a.z) + w1 * bflo(b.z); f[8 * c + 5] = w0 * bfhi(a.z) + w1 * bfhi(b.z); f[8 * c + 6] = w0 * bflo(a.w) + w1 * bflo(b.w); f[8 * c + 7] = w0 * bfhi(a.w) + w1 * bfhi(b.w);
                    continue; }
                const v4u w = *(const GAS v4u*)(O + (size_t)m * DM + g * GW + c * 512 + 8 * lane);
                f[8 * c + 0] = bflo(w.x); f[8 * c + 1] = bfhi(w.x); f[8 * c + 2] = bflo(w.y); f[8 * c + 3] = bfhi(w.y); f[8 * c + 4] = bflo(w.z); f[8 * c + 5] = bfhi(w.z); f[8 * c + 6] = bflo(w.w); f[8 * c + 7] = bfhi(w.w); }
#pragma unroll
            for (int e = 0; e < 16; ++e) s += f[e] * f[e];
            const float rstd = 1.f / sqrtf(wave_sum(s) * (1.f / GW) + EPS);
#pragma unroll
            for (int c = 0; c < 2; ++c) { const float* g8 = go + g * GW + c * 512 + 8 * lane; v4u o;
                o.x = pk2(f[8 * c + 0] * rstd * g8[0], f[8 * c + 1] * rstd * g8[1]); o.y = pk2(f[8 * c + 2] * rstd * g8[2], f[8 * c + 3] * rstd * g8[3]);
                o.z = pk2(f[8 * c + 4] * rstd * g8[4], f[8 * c + 5] * rstd * g8[5]); o.w = pk2(f[8 * c + 6] * rstd * g8[6], f[8 * c + 7] * rstd * g8[7]);
                *(GAS v4u*)(ON + (size_t)m * DM + g * GW + c * 512 + 8 * lane) = o; }
        }
    }
}

#ifndef DUP
#define DUP 0
#endif
#ifndef DUPV
#define DUPV 15
#endif
#ifndef MK_N_LAUNCHES
#define MK_N_LAUNCHES 1
#endif
constexpr int N_PHASES = 22;
struct Args { const float* in[15]; float* out; unsigned char* ws; int ph_lo, ph_hi; };
__global__ void __launch_bounds__(NWAVES * 64, 2) fwd_kernel(Args args) {
    extern __shared__ __attribute__((aligned(16))) unsigned char lds[];
    Frame F;
    F.lds = (LAS unsigned char*)lds;
    F.MISC = (volatile LAS unsigned*)(F.lds + MISC_OFF);
    F.tid = threadIdx.x; F.lane = 0; F.wave = 0;
    F.G = gridDim.x;
    F.ctl = (gu32*)(args.ws + WS_CTL);
    Ptrs P;
    P.x = args.in[0]; P.g_attn = args.in[1]; P.w_in = args.in[2]; P.g_q = args.in[3]; P.g_kv = args.in[4]; P.w_uq = args.in[5]; P.w_uk = args.in[6]; P.w_uv = args.in[7];
    P.b_f = args.in[8]; P.g_out = args.in[9]; P.w_o = args.in[10]; P.g_mlp = args.in[11]; P.w_up = args.in[12]; P.w_down = args.in[13]; P.g_final = args.in[14];
    P.out = args.out; P.ws = args.ws;
    for (int u = F.tid; u < (LDS_BYTES - LDSCTL_OFF) / 4; u += NWAVES * 64) ((LAS unsigned*)(F.lds + LDSCTL_OFF))[u] = 0u;
    __syncthreads();
    XcdBarrier bar; bar.bar = (unsigned*)(F.ctl + CW_BAR); bar.x = 0; bar.st = nullptr;
    if (MK_N_LAUNCHES == 1) bar = xcd_barrier_post((unsigned*)(F.ctl + CW_BAR), F.MISC + 8);
    const int lo = args.ph_lo, hi = args.ph_hi;
#define IN(k) (lo <= (k) && (k) < hi)
#define SEAM(k) do { if (IN(k) && IN((k) + 1)) xcd_barrier(bar); } while (0)

    if (IN(0)) { LFRAME; p0_prologue(Fl, P, 0, 0); } SEAM(0);
    for (int l = 0; l < 2; ++l) {
        const int pb = 1 + 10 * l; const size_t wb = WS_W0 + (size_t)l * WS_WSTRIDE;
        if (false) { LFRAME; p0_prologue(Fl, P, 1, 0); xcd_barrier(bar); }
        const float* xin = (l == 0) ? P.x : wsf(P, WS_X1);
        if (IN(pb + 1)) {
            pg8::Gemm g{wsb(P, WS_XB), wsb(P, wb + WO_IN), S, NMAIN, DM, DM, DM}; pg8::StaticOrder So; So.init(S, NMAIN, F.G, (int)blockIdx.x);
            pg8::EpiBf16<0> E{wsb(P, WS_PROJ), NP, wsf(P, WS_PF), PC_F, (const float*)(F.ctl + CW_SS) + (size_t)(2 * l) * S, 1.f / DM, wsb(P, WS_H), DM, 6, wsf(P, WS_CQ), 11, nullptr, 0, 0};
            pg8::gemm_phase<pg8::EpiBf16<0>, pg8::StaticOrder, true, true>(F.lds + RING_OFF, g, So, E);
        } SEAM(pb + 1);
        if (IN(pb + 2)) {
            const size_t w2 = WS_WUP2 + (size_t)l * 28 * MiB;
            pg8::Gemm g{wsb(P, WS_XB), wsb(P, wb + WO_IN), S, NP, DM, DM, DM, wsb(P, WS_H) + PC_CQ, wsb(P, w2), QLR, wsb(P, WS_H) + PC_CKV, wsb(P, w2 + 12 * MiB), KVLR};
            pg8::MixOrder Sm{F.G, (int)blockIdx.x, NMAIN / 256};
            pg8::EpiMix E{ {wsb(P, WS_PROJ), NP, nullptr, 0, (const float*)(F.ctl + CW_SS) + (size_t)(2 * l) * S, 1.f / DM, nullptr, 0, 0, nullptr, 0, nullptr, 0, 0},
                           {wsb(P, WS_QA), NQA, nullptr, 0, nullptr, 1.f / QLR, nullptr, 0, 0, nullptr, 0, wsf(P, WS_CQ), 0, 28},
                           {wsb(P, WS_KVU), NKVU, nullptr, 0, nullptr, 1.f / KVLR, nullptr, 0, 0, nullptr, 0, wsf(P, WS_CQ), 28, 16} };
            pg8::gemm_phase<pg8::EpiMix, pg8::MixOrder, true, true>(F.lds + RING_OFF, g, Sm, E);
            { const int b0 = (F.G == 256) ? 64 : 0, nb_ = F.G - b0;
              if ((int)blockIdx.x >= b0) { LFRAME; if ((int)blockIdx.x - b0 < NH) cumsum_head(Fl, P, (int)blockIdx.x - b0, l); postproj_rows(Fl, P, l, b0, nb_); } }
        } SEAM(pb + 2);
        if (IN(pb + 4)) { LFRAME; if (FASTMASK != 0) fast_attn_phase(Fl, P, l); if (FASTMASK != 15) slow_attn_phase(Fl, P); if (DUP & 2) { xcd_barrier(bar); fast_attn_phase(Fl, P, l + 2, DUPV); } } SEAM(pb + 4);
        if (IN(pb + 5)) { LFRAME; groupnorm_rows(Fl, P, l);     if (DUP & 4) { xcd_barrier(bar); groupnorm_rows(Fl, P, l); } } SEAM(pb + 5);
        if (IN(pb + 6)) {
            pg8::Gemm g{wsb(P, WS_H), wsb(P, wb + WO_O), S, DM, DM, DM, DM}; pg8::StaticOrder So; So.init(S, DM, F.G, (int)blockIdx.x);
            pg8::EpiResid E{xin, wsf(P, WS_X1), DM, wsb(P, WS_XB), (float*)(F.ctl + CW_SS) + (size_t)(2 * l + 1) * S};
            pg8::gemm_phase<pg8::EpiResid, pg8::StaticOrder, true, true>(F.lds + RING_OFF, g, So, E);
        } SEAM(pb + 6);
        if (IN(pb + 8)) {
            pg8::Gemm g{wsb(P, WS_XB), wsb(P, wb + WO_UP), S, DFF, DM, DM, DM}; pg8::StaticOrder So; So.init(S, DFF, F.G, (int)blockIdx.x);
            pg8::EpiBf16<2> E{wsb(P, WS_U), DFF, nullptr, 0, (const float*)(F.ctl + CW_SS) + (size_t)(2 * l + 1) * S, 1.f / DM};
            pg8::gemm_phase<pg8::EpiBf16<2>, pg8::StaticOrder, true, true>(F.lds + RING_OFF, g, So, E);
        } SEAM(pb + 8);
        if (IN(pb + 9)) {
            pg8::Gemm g{wsb(P, WS_U), wsb(P, wb + WO_DN), S, DM, DFF, DFF, DFF}; pg8::StaticOrder So; So.init(S, DM, F.G, (int)blockIdx.x);
            pg8::EpiResid E{wsf(P, WS_X1), wsf(P, WS_X1), DM, (l == 0) ? wsb(P, WS_XB) : (bf16*)nullptr, (float*)(F.ctl + CW_SS) + (size_t)(2 * l + 2) * S};
            pg8::gemm_phase<pg8::EpiResid, pg8::StaticOrder, true, true>(F.lds + RING_OFF, g, So, E);
        } SEAM(pb + 9);
    }
    if (IN(21)) { LFRAME; rms_rows<true>(Fl, wsf(P, WS_X1), P.g_final, nullptr, P.out); if (DUP & 4) { xcd_barrier(bar); rms_rows<true>(Fl, wsf(P, WS_X1), P.g_final, nullptr, P.out); } }
#undef IN
#undef SEAM
}

extern "C" void kernel_launch(void* const* d_in, const int* in_sizes, int n_in, void* d_out, int out_size, void* d_ws, size_t ws_size, hipStream_t stream) {
    static int grid = 0;
    if (grid == 0) {
        if (n_in != 15 || out_size != S * DM || ws_size < WS_END) { fprintf(stderr, "kernel_launch: unexpected shapes (n_in %d out %d ws %zu, need %zu)\n", n_in, out_size, ws_size, (size_t)WS_END); grid = -1; return; }
        int dev = 0, cus = 0, per_cu = 0;
        if (hipGetDevice(&dev) != hipSuccess || hipDeviceGetAttribute(&cus, hipDeviceAttributeMultiprocessorCount, dev) != hipSuccess) { grid = -1; return; }
        if (hipFuncSetAttribute((const void*)fwd_kernel, hipFuncAttributeMaxDynamicSharedMemorySize, LDS_BYTES) != hipSuccess) { fprintf(stderr, "kernel_launch: hipFuncSetAttribute failed\n"); grid = -1; return; }
        if (hipOccupancyMaxActiveBlocksPerMultiprocessor(&per_cu, (const void*)fwd_kernel, NWAVES * 64, LDS_BYTES) != hipSuccess || per_cu < 1) fprintf(stderr, "kernel_launch: occupancy query says %d\n", per_cu);
        (void)hipGetLastError();
        grid = cus;
    }
    if (grid < 0) return;
    if (hipMemsetAsync((char*)d_ws + WS_CTL, 0, CTL_ZERO_BYTES, stream) != hipSuccess) return;
    Args a{};
    for (int i = 0; i < 15; ++i) a.in[i] = (const float*)d_in[i];
    a.out = (float*)d_out; a.ws = (unsigned char*)d_ws;
    if (MK_N_LAUNCHES == 1) { a.ph_lo = 0; a.ph_hi = N_PHASES; hipLaunchKernelGGL(fwd_kernel, dim3(grid), dim3(NWAVES * 64), LDS_BYTES, stream, a); }
    else { for (int p = 0; p < N_PHASES; ++p) { a.ph_lo = p; a.ph_hi = p + 1; hipLaunchKernelGGL(fwd_kernel, dim3(grid), dim3(NWAVES * 64), LDS_BYTES, stream, a); } }
}
```

```cpp
#include <hip/hip_runtime.h>
#include <cstdio>
#include <cstdint>
namespace pg8 {
#define PG8_LAS __attribute__((address_space(3)))
typedef unsigned short bf16_t;
typedef short bf16x8 __attribute__((ext_vector_type(8)));
typedef float f32x4 __attribute__((ext_vector_type(4)));
typedef unsigned u32x4 __attribute__((ext_vector_type(4)));
constexpr int BM = 256, BK = 64, HALF = 128, HTB = HALF * BK * 2  , STAGE_BYTES = 8 * HTB, NXCD = 8, WGM = 8;

__host__ __device__ __forceinline__ int lds_byte(int r, int c) { const int st = (r >> 4) * 2 + (c >> 5), rr = r & 15, cc = c & 31, ob = rr * 64 + cc * 2; return st * 1024 + (ob ^ (((ob >> 9) & 1) << 5)); }
__host__ __device__ __forceinline__ void stage_rc(int b, int& R, int& C) { const int st = b / 1024, sb = b % 1024, swz = sb ^ (((sb >> 9) & 1) << 5); R = (st >> 1) * 16 + swz / 64; C = (st & 1) * 32 + (swz % 64) / 2; }
__host__ __device__ __forceinline__ int perm32(int rho) { const int n = rho >> 4, i = rho & 15; return 8 * (i >> 2) + 4 * n + (i & 3); }

struct Unit { int pm, pn, ty; };
struct Gemm { const bf16_t* A; const bf16_t* Bt; int M, N, K, lda, ldb; const bf16_t* A1; const bf16_t* B1; int K1; const bf16_t* A2; const bf16_t* B2; int K2; };

struct StaticOrder {
    int nM, nN, nwg, G, c;
    __host__ __device__ void init(int M, int N, int G_, int c_) { nM = M / BM; nN = N / BM; nwg = nM * nN; G = G_; c = c_; }
    __host__ __device__ bool next(int i, Unit& u) const {
        const long L = (long)i * G + c; if (L >= nwg) return false;
        int wgid = (int)L; { const int q = nwg / NXCD, r = nwg % NXCD, xcd = wgid % NXCD, off = wgid / NXCD; wgid = (xcd < r ? xcd * (q + 1) : r * (q + 1) + (xcd - r) * q) + off; }
        const int nig = WGM * nN, gid = wgid / nig, fm = gid * WGM, gsz = (nM - fm) < WGM ? (nM - fm) : WGM;
        u.pm = fm + ((wgid % nig) % gsz); u.pn = (wgid % nig) / gsz; u.ty = 0; return true;
    }
    __device__ __forceinline__ void a_ready(const Unit&) const {}
    __device__ __forceinline__ void done(const Unit&) const {}
};
struct MixOrder {
    int G, c, pn0;
    __device__ bool dec(int L, Unit& u) const {
        if (L < 64) { u.ty = 0; u.pm = L & 31; u.pn = pn0 + (L >> 5); return true; }
        if (L < 256) { const int r = L - 64; u.ty = 1; u.pm = r & 31; u.pn = r >> 5; return true; }
        if (L < 512) { const int r = L - 256; u.ty = 2; u.pm = r & 31; u.pn = r >> 5; return true; }
        return false; }
    __device__ bool next(int i, Unit& u) const {
        if (G == 256) { if (c < 64) return i == 0 ? dec(c, u) : false; const int r = c - 64; if (i == 0) return dec(64 + r, u); if (i == 1) return dec(256 + r, u); if (i == 2 && r < 64) return dec(256 + 192 + r, u); return false; }
        return dec(i * G + c, u); }
    __device__ __forceinline__ void a_ready(const Unit&) const {}
    __device__ __forceinline__ void done(const Unit&) const {}
};


__device__ __forceinline__ unsigned cvt_pk_bf16(float lo, float hi) { unsigned r; asm volatile("v_cvt_pk_bf16_f32 %0, %1, %2" : "=v"(r) : "v"(lo), "v"(hi)); return r; }
template <int ACT> struct EpiBf16 {
    static constexpr bool PERM = true, AFTER_DRAIN = false;
    bf16_t* O; int ldc; float* side; int side_col; const float* ss; float inv_n;
    bf16_t* O2; int ldc2; int ntile2; float* ssp; int hb_n; const float* ssr; int p0, np;
    __device__ __forceinline__ void operator()(const f32x4 (&acc)[2][2][4][2], const Unit& u, int wr, int wc, int fr, int fq) const {
        const int row0 = u.pm * BM + wr * 64 + fr; const int col0 = u.pn * BM + wc * 32 + 8 * fq;
#pragma unroll
        for (int ai = 0; ai < 2; ++ai)
#pragma unroll
            for (int m = 0; m < 4; ++m) { const int row = row0 + ai * HALF + m * 16; bf16_t* rowp = O + (size_t)row * ldc + col0;
                float rs = (ss != nullptr) ? __builtin_amdgcn_rsqf(ss[row] * inv_n + 1e-6f) : 1.f;
                if (ssr != nullptr) { const f32x4* pr = (const f32x4*)(ssr + (size_t)row * 44 + p0); f32x4 a = pr[0];
                    for (int q = 1; q < np / 4; ++q) a += pr[q];
                    rs = __builtin_amdgcn_rsqf(((a[0] + a[1]) + (a[2] + a[3])) * inv_n + 1e-6f); }
#pragma unroll
                for (int bj = 0; bj < 2; ++bj) { f32x4 v0 = acc[ai][bj][m][0] * rs, v1 = acc[ai][bj][m][1] * rs;
                    if (side != nullptr && col0 + bj * HALF == side_col) { *(f32x4*)(side + (size_t)row * 8) = v0; *(f32x4*)(side + (size_t)row * 8 + 4) = v1; }
                    if (ACT == 2) {
#pragma unroll
                        for (int e = 0; e < 4; ++e) { const float a = fmaxf(v0[e], 0.f), b = fmaxf(v1[e], 0.f); v0[e] = a * a; v1[e] = b * b; } }
                    u32x4 w; w.x = cvt_pk_bf16(v0[0], v0[1]); w.y = cvt_pk_bf16(v0[2], v0[3]); w.z = cvt_pk_bf16(v1[0], v1[1]); w.w = cvt_pk_bf16(v1[2], v1[3]);
                    *(u32x4*)(rowp + bj * HALF) = w;
                    if (O2 != nullptr && u.pn < ntile2) { *(u32x4*)(O2 + (size_t)row * ldc2 + col0 + bj * HALF) = w;
                        const int hb = 2 * u.pn + bj;
                        if (hb < hb_n) { float sq = (v0[0] * v0[0] + v0[1] * v0[1]) + (v0[2] * v0[2] + v0[3] * v0[3]) + (v1[0] * v1[0] + v1[1] * v1[1]) + (v1[2] * v1[2] + v1[3] * v1[3]);
                            sq += __shfl_xor(sq, 16); sq += __shfl_xor(sq, 32); if (fq == 0) ssp[(size_t)row * 44 + 4 * hb + wc] = sq; } } } }
    }
};
struct EpiMix {
    static constexpr bool PERM = true, AFTER_DRAIN = false;
    EpiBf16<0> e0, e1, e2;
    __device__ __forceinline__ void operator()(const f32x4 (&acc)[2][2][4][2], const Unit& u, int wr, int wc, int fr, int fq) const {
        if (u.ty == 0) e0(acc, u, wr, wc, fr, fq); else if (u.ty == 1) e1(acc, u, wr, wc, fr, fq); else e2(acc, u, wr, wc, fr, fq);
    }
};
struct EpiResid {
    static constexpr bool PERM = true, AFTER_DRAIN = false;
    const float* R; float* O; int ldc; bf16_t* XB; float* ssq;
    __device__ __forceinline__ void operator()(const f32x4 (&acc)[2][2][4][2], const Unit& u, int wr, int wc, int fr, int fq) const {
        const int row0 = u.pm * BM + wr * 64 + fr; const int col0 = u.pn * BM + wc * 32 + 8 * fq;
#pragma unroll
        for (int ai = 0; ai < 2; ++ai)
#pragma unroll
            for (int m = 0; m < 4; ++m) { const int row = row0 + ai * HALF + m * 16; const size_t off = (size_t)row * ldc + col0; float sq = 0.f;
#pragma unroll
                for (int bj = 0; bj < 2; ++bj) { const f32x4 r0 = *(const f32x4*)(R + off + bj * HALF), r1 = *(const f32x4*)(R + off + bj * HALF + 4);
                    const f32x4 y0 = r0 + acc[ai][bj][m][0], y1 = r1 + acc[ai][bj][m][1];
                    *(f32x4*)(O + off + bj * HALF) = y0; *(f32x4*)(O + off + bj * HALF + 4) = y1;
                    if (XB != nullptr) { u32x4 w; w.x = cvt_pk_bf16(y0[0], y0[1]); w.y = cvt_pk_bf16(y0[2], y0[3]); w.z = cvt_pk_bf16(y1[0], y1[1]); w.w = cvt_pk_bf16(y1[2], y1[3]); *(u32x4*)(XB + off + bj * HALF) = w;
                        sq += (y0[0] * y0[0] + y0[1] * y0[1]) + (y0[2] * y0[2] + y0[3] * y0[3]) + (y1[0] * y1[0] + y1[1] * y1[1]) + (y1[2] * y1[2] + y1[3] * y1[3]); } }
                if (XB != nullptr) { sq += __shfl_xor(sq, 16); sq += __shfl_xor(sq, 32); if (fq == 0) atomicAdd(ssq + row, sq); } }
    }
};

template <class Epi, class Sched, bool ALIGN_EPI = false, bool SP2 = false>
__device__ __forceinline__ void gemm_phase(PG8_LAS unsigned char* lds, const Gemm g, const Sched& S, const Epi& E) {
    int tid_ = threadIdx.x; asm volatile("" : "+v"(tid_));
    const int tid = tid_, wid = __builtin_amdgcn_readfirstlane(tid >> 6), lane = tid & 63, wr = wid >> 2, wc = wid & 3, fr = lane & 15, fq = lane >> 4;
#define PG8_UA(u) ((const char*)((u).ty == 0 ? g.A : (u).ty == 1 ? g.A1 : g.A2))
#define PG8_UB(u) ((const char*)((u).ty == 0 ? g.Bt : (u).ty == 1 ? g.B1 : g.B2))
#define PG8_UK(u) ((u).ty == 0 ? g.K : (u).ty == 1 ? g.K1 : g.K2)
    unsigned voffA[2], voffB[2];
#pragma unroll
    for (int i = 0; i < 2; ++i) { int R, C; stage_rc(tid * 16 + i * 8192, R, C); const int Rb = Epi::PERM ? ((R & ~31) + perm32(R & 31)) : R;
        voffA[i] = (unsigned)(R * g.lda + C) * 2u; voffB[i] = (unsigned)(Rb * g.ldb + C) * 2u; }
    const size_t kstep = (size_t)(BK * 2);
    const size_t hstepA = (size_t)HALF * g.lda * 2, hstepB = (size_t)HALF * g.ldb * 2;
    const size_t tstepA = 2 * hstepA, tstepB = 2 * hstepB;
    const unsigned ldsw = (unsigned)wid * 1024u;
    const int aoff = lds_byte(wr * 64 + fr, fq * 8), boff = lds_byte(wc * 32 + fr, fq * 8);
#define PG8_SA(b, h) (((b) * 2 + (h)) * HTB)
#define PG8_SB(b, h) ((4 + (b) * 2 + (h)) * HTB)
#define PG8_STAGE(bufoff, gbase, voff) do { _Pragma("unroll") for (int _i = 0; _i < 2; ++_i) \
        __builtin_amdgcn_global_load_lds((const unsigned*)((const char*)(gbase) + (voff)[_i]), (PG8_LAS unsigned*)(lds + (bufoff) + ldsw + _i * 8192), 16, 0, 0); } while (0)
#define PG8_LDA(dst, b, h) do { _Pragma("unroll") for (int m = 0; m < 4; ++m) _Pragma("unroll") for (int k = 0; k < 2; ++k) dst[m][k] = *(const PG8_LAS bf16x8*)(lds + PG8_SA(b, h) + aoff + m * 2048 + k * 1024); } while (0)
#define PG8_LDB(dst, b, h) do { _Pragma("unroll") for (int n = 0; n < 2; ++n) _Pragma("unroll") for (int k = 0; k < 2; ++k) dst[n][k] = *(const PG8_LAS bf16x8*)(lds + PG8_SB(b, h) + boff + n * 2048 + k * 1024); } while (0)
#define PG8_MMA(ai, bj, At, Bt) do { __builtin_amdgcn_s_setprio(1); _Pragma("unroll") for (int m = 0; m < 4; ++m) _Pragma("unroll") for (int n = 0; n < 2; ++n) _Pragma("unroll") for (int k = 0; k < 2; ++k) \
        acc[ai][bj][m][n] = __builtin_amdgcn_mfma_f32_16x16x32_bf16(Bt[n][k], At[m][k], acc[ai][bj][m][n], 0, 0, 0); __builtin_amdgcn_s_setprio(0); } while (0)
#define PG8_WAIT_V(n) asm volatile("s_waitcnt vmcnt(" #n ")" ::: "memory")
#define PG8_WAIT_L(n) asm volatile("s_waitcnt lgkmcnt(" #n ")" ::: "memory")
#define PG8_BAR __builtin_amdgcn_s_barrier()
#define PG8_SCHED __builtin_amdgcn_sched_barrier(0)
    Unit cur, nxt; int ui = 0;
    if (!S.next(0, cur)) return;
    f32x4 acc[2][2][4][2];
#pragma unroll
    for (int a = 0; a < 2; ++a)
#pragma unroll
        for (int b = 0; b < 2; ++b)
#pragma unroll
            for (int m = 0; m < 4; ++m)
#pragma unroll
                for (int n = 0; n < 2; ++n) acc[a][b][m][n] = (f32x4){0.f, 0.f, 0.f, 0.f};
    bf16x8 At[4][2], B0[2][2], B1[2][2];
    const char* cA = PG8_UA(cur) + (size_t)cur.pm * tstepA; const char* cB = PG8_UB(cur) + (size_t)cur.pn * tstepB;
    S.a_ready(cur);
    if constexpr (SP2) {
        PG8_STAGE(PG8_SB(0, 0), cB, voffB); PG8_STAGE(PG8_SB(0, 1), cB + hstepB, voffB); PG8_STAGE(PG8_SA(0, 0), cA, voffA); PG8_STAGE(PG8_SA(0, 1), cA + hstepA, voffA);
        if (wr == 1) PG8_BAR;
        PG8_WAIT_V(2); PG8_BAR;
        PG8_STAGE(PG8_SB(1, 0), cB + kstep, voffB); PG8_STAGE(PG8_SA(1, 0), cA + kstep, voffA); PG8_STAGE(PG8_SB(1, 1), cB + hstepB + kstep, voffB);
        PG8_WAIT_V(6); PG8_BAR;
    } else {
        PG8_STAGE(PG8_SB(0, 0), cB, voffB); PG8_STAGE(PG8_SA(0, 0), cA, voffA); PG8_STAGE(PG8_SB(0, 1), cB + hstepB, voffB); PG8_STAGE(PG8_SA(0, 1), cA + hstepA, voffA);
        if (wr == 1) PG8_BAR;
        PG8_WAIT_V(4); PG8_BAR;
        PG8_STAGE(PG8_SB(1, 0), cB + kstep, voffB); PG8_STAGE(PG8_SA(1, 0), cA + kstep, voffA); PG8_STAGE(PG8_SB(1, 1), cB + hstepB + kstep, voffB);
        PG8_WAIT_V(6); PG8_BAR;
    }
    for (;;) {
        const bool has_next = S.next(ui + 1, nxt);
        const char* nA = has_next ? PG8_UA(nxt) + (size_t)nxt.pm * tstepA : cA; const char* nB = has_next ? PG8_UB(nxt) + (size_t)nxt.pn * tstepB : cB;
        const int nt = PG8_UK(cur) / BK;
        for (int t = 0; t < nt; t += 2) {
            const bool last = (t == nt - 2);
            const char* a1 = cA + (size_t)(t + 1) * kstep;
            const char* a2 = last ? nA : cA + (size_t)(t + 2) * kstep; const char* b2 = last ? nB : cB + (size_t)(t + 2) * kstep;
            const char* a3 = a2 + kstep; const char* b3 = b2 + kstep;
            if (last && has_next) S.a_ready(nxt);
            if constexpr (SP2) {
            PG8_LDB(B0, 0, 0); PG8_LDB(B1, 0, 1); PG8_SCHED; PG8_LDA(At, 0, 0); PG8_STAGE(PG8_SA(1, 1), a1 + hstepA, voffA);
            PG8_WAIT_V(8); PG8_WAIT_L(0); PG8_BAR; PG8_MMA(0, 0, At, B0); PG8_MMA(0, 1, At, B1); PG8_BAR; PG8_SCHED;
            PG8_LDA(At, 0, 1); PG8_STAGE(PG8_SB(0, 0), b2, voffB); PG8_STAGE(PG8_SB(0, 1), b2 + hstepB, voffB); PG8_STAGE(PG8_SA(0, 0), a2, voffA);
            PG8_WAIT_V(8); PG8_WAIT_L(0); PG8_BAR; PG8_MMA(1, 0, At, B0); PG8_MMA(1, 1, At, B1); PG8_BAR; PG8_SCHED;
            PG8_LDB(B0, 1, 0); PG8_LDB(B1, 1, 1); PG8_SCHED; PG8_LDA(At, 1, 0); PG8_STAGE(PG8_SA(0, 1), a2 + hstepA, voffA);
            PG8_WAIT_V(8); PG8_WAIT_L(0); PG8_BAR; PG8_MMA(0, 0, At, B0); PG8_MMA(0, 1, At, B1); PG8_BAR; PG8_SCHED;
            PG8_LDA(At, 1, 1); PG8_STAGE(PG8_SB(1, 0), b3, voffB); PG8_STAGE(PG8_SB(1, 1), b3 + hstepB, voffB); PG8_STAGE(PG8_SA(1, 0), a3, voffA);
            PG8_WAIT_V(8); PG8_WAIT_L(0); PG8_BAR; PG8_MMA(1, 0, At, B0); PG8_MMA(1, 1, At, B1); PG8_BAR; PG8_SCHED;
            } else {
            PG8_LDB(B0, 0, 0); PG8_SCHED; PG8_LDA(At, 0, 0); PG8_STAGE(PG8_SA(1, 1), a1 + hstepA, voffA);
            PG8_WAIT_L(8); PG8_BAR; PG8_WAIT_L(0); PG8_MMA(0, 0, At, B0); PG8_BAR; PG8_SCHED;
            PG8_LDB(B1, 0, 1); PG8_STAGE(PG8_SB(0, 0), b2, voffB);
            PG8_BAR; PG8_WAIT_L(0); PG8_MMA(0, 1, At, B1); PG8_BAR;
            PG8_LDA(At, 0, 1); PG8_STAGE(PG8_SA(0, 0), a2, voffA);
            PG8_BAR; PG8_WAIT_L(0); PG8_MMA(1, 0, At, B0); PG8_BAR; PG8_SCHED;
            PG8_STAGE(PG8_SB(0, 1), b2 + hstepB, voffB);
            PG8_WAIT_V(6); PG8_BAR; PG8_MMA(1, 1, At, B1); PG8_BAR;
            PG8_LDB(B0, 1, 0); PG8_SCHED; PG8_LDA(At, 1, 0); PG8_STAGE(PG8_SA(0, 1), a2 + hstepA, voffA);
            PG8_WAIT_L(8); PG8_BAR; PG8_WAIT_L(0); PG8_MMA(0, 0, At, B0); PG8_BAR; PG8_SCHED;
            PG8_LDB(B1, 1, 1); PG8_STAGE(PG8_SB(1, 0), b3, voffB);
            PG8_BAR; PG8_WAIT_L(0); PG8_MMA(0, 1, At, B1); PG8_BAR;
            PG8_LDA(At, 1, 1); PG8_STAGE(PG8_SA(1, 0), a3, voffA);
            PG8_BAR; PG8_WAIT_L(0); PG8_MMA(1, 0, At, B0); PG8_BAR; PG8_SCHED;
            PG8_STAGE(PG8_SB(1, 1), b3 + hstepB, voffB);
            PG8_WAIT_V(6); PG8_BAR; PG8_MMA(1, 1, At, B1); PG8_BAR;
            }
        }
        if constexpr (ALIGN_EPI) { if (wr == 0) PG8_BAR; }
        if constexpr (!Epi::AFTER_DRAIN) { E(acc, cur, wr, wc, fr, fq); S.done(cur); }
        if (!has_next) break;
#pragma unroll
        for (int a = 0; a < 2; ++a)
#pragma unroll
            for (int b = 0; b < 2; ++b)
#pragma unroll
                for (int m = 0; m < 4; ++m)
#pragma unroll
                    for (int n = 0; n < 2; ++n) acc[a][b][m][n] = (f32x4){0.f, 0.f, 0.f, 0.f};
        cur = nxt; cA = nA; cB = nB; ++ui;
        if constexpr (ALIGN_EPI) { if (wr == 1) PG8_BAR; }
    }
    PG8_WAIT_V(0);
    if constexpr (!ALIGN_EPI) { if (wr == 0) PG8_BAR; }
    PG8_BAR;
    if constexpr (Epi::AFTER_DRAIN) { E.fused(acc, cur, wr, wc, fr, fq, lds, wid, lane); S.done(cur); }
#undef PG8_UA
#undef PG8_UB
#undef PG8_UK
#undef PG8_SA
#undef PG8_SB
#undef PG8_STAGE
#undef PG8_LDA
#undef PG8_LDB
#undef PG8_MMA
#undef PG8_WAIT_V
#undef PG8_WAIT_L
#undef PG8_BAR
#undef PG8_SCHED
}
}
#define GAS __attribute__((address_space(1)))
#define LAS __attribute__((address_space(3)))
typedef unsigned short bf16;
typedef unsigned v4u __attribute__((ext_vector_type(4)));
typedef float f32x4 __attribute__((ext_vector_type(4)));
typedef short bf16x8 __attribute__((ext_vector_type(8)));
typedef GAS unsigned gu32;
typedef GAS unsigned long long gu64;
#define RLX_AGENT __ATOMIC_RELAXED, __HIP_MEMORY_SCOPE_AGENT
#define LDS_WAIT() asm volatile("s_waitcnt lgkmcnt(0)" ::: "memory")
#define VM_WAIT() asm volatile("s_waitcnt vmcnt(0)" ::: "memory")
__device__ __forceinline__ unsigned long long rt() { return __builtin_amdgcn_s_memrealtime(); }
__device__ __forceinline__ unsigned f2bf(float f) { unsigned u = __builtin_bit_cast(unsigned, f); return (u + 0x7fffu + ((u >> 16) & 1u)) >> 16; }
__device__ __forceinline__ unsigned pk2(float lo, float hi) { return f2bf(lo) | (f2bf(hi) << 16); }

#define XB_TMO      128
#define XB_XCNT(j)  (256  + 64 * (j))
#define XB_XSUB(j)  (1280 + 64 * (j))
#define XB_XGEN(j)  (2304 + 64 * (j))
#define XB_TOP      3328
#define XB_TOPGEN   3392
#define XCD_BAR_WORDS 3456
#define XB_SPIN_CAP (1u << 18)

__device__ __forceinline__ unsigned xb_ld(unsigned* p)              { return __hip_atomic_load(p, __ATOMIC_RELAXED, __HIP_MEMORY_SCOPE_AGENT); }
__device__ __forceinline__ unsigned xb_add(unsigned* p, unsigned v) { return __hip_atomic_fetch_add(p, v, __ATOMIC_RELAXED, __HIP_MEMORY_SCOPE_AGENT); }
__device__ __forceinline__ unsigned xb_xcc_id() { return (unsigned)__builtin_amdgcn_s_getreg((3 << 11) | 20) & 0xFu; }
#define XB_SPIN(cond, bar) do { unsigned _sp = 0; while (cond) { __builtin_amdgcn_s_sleep(1); \
    if ((++_sp & 255u) == 0u) { if (xb_ld(&(bar)[XB_TMO])) break; if (_sp > XB_SPIN_CAP) { atomicAdd(&(bar)[XB_TMO], 1u); break; } } } } while (0)

struct XcdBarrier {
    unsigned* bar; unsigned x;
    volatile LAS unsigned* st;
};

__device__ __forceinline__ XcdBarrier xcd_barrier_post(unsigned* bar, volatile LAS unsigned* st) {
    XcdBarrier b; b.bar = bar; b.x = xb_xcc_id(); b.st = st;
    if (threadIdx.x == 0) (void)xb_add(&bar[XB_XCNT(b.x)], 1u);
    return b;
}
__device__ __forceinline__ void xcd_barrier_complete(unsigned* bar, unsigned x, unsigned& nloc, unsigned& nx) {
    const unsigned G = gridDim.x * gridDim.y * gridDim.z;
    unsigned sum, cnt, mine, sp = 0u;
    for (;;) {
        sum = 0u; cnt = 0u; mine = 0u;
#pragma unroll
        for (unsigned j = 0; j < 16; ++j) { const unsigned c = xb_ld(&bar[XB_XCNT(j)]); sum += c; cnt += (c > 0u) ? 1u : 0u; mine = (j == x) ? c : mine; }
        if (sum == G) break;
        __builtin_amdgcn_s_sleep(1);
        if ((++sp & 255u) == 0u) { if (xb_ld(&bar[XB_TMO])) break; if (sp > XB_SPIN_CAP) { atomicAdd(&bar[XB_TMO], 1u); break; } }
    }
    nloc = mine > 0u ? mine : 1u; nx = cnt > 0u ? cnt : 1u;
}

__device__ __forceinline__ void xcd_barrier(const XcdBarrier& b) {
    asm volatile("s_waitcnt vmcnt(0)" ::: "memory");
    __syncthreads();
    if (threadIdx.x == 0) {
        unsigned* bar = b.bar;
        __builtin_amdgcn_s_waitcnt(0);
        unsigned nloc = b.st[0], nx = b.st[1];
        if (nloc == 0u) { xcd_barrier_complete(bar, b.x, nloc, nx); b.st[0] = nloc; b.st[1] = nx; }
        const unsigned old = xb_add(&bar[XB_XSUB(b.x)], 1u);
        const unsigned gen = old / nloc;
        if (old + 1u == (gen + 1u) * nloc) {
            __builtin_amdgcn_fence(__ATOMIC_RELEASE, "agent");
            asm volatile("s_waitcnt vmcnt(0)" ::: "memory");
            const unsigned og = xb_add(&bar[XB_TOP], 1u);
            const unsigned tg = og / nx;
            if (og + 1u == (tg + 1u) * nx) xb_add(&bar[XB_TOPGEN], 1u);
            else XB_SPIN(xb_ld(&bar[XB_TOPGEN]) == tg, bar);
            __builtin_amdgcn_fence(__ATOMIC_ACQUIRE, "agent");
            xb_add(&bar[XB_XGEN(b.x)], 1u);
            asm volatile("s_waitcnt vmcnt(0)" ::: "memory");
        } else {
            XB_SPIN(xb_ld(&bar[XB_XGEN(b.x)]) == gen, bar);
            __builtin_amdgcn_fence(__ATOMIC_ACQUIRE, "agent");
            asm volatile("s_waitcnt vmcnt(0)" ::: "memory");
        }
    }
    __syncthreads();
}

constexpr int NWAVES = 8;
constexpr int S = 8192, DM = 4096, NP = 10752, INC = 10696, QLR = 896, KVLR = 512, NQA = 1536, NKVU = 2048, DFF = 16384, NH = 8, HD = 128, GW = 1024;
constexpr int NMAIN = 10240;
constexpr int PC_CQ = 0, PC_CKV = 896, PC_KR = 1408, PC_F = 1472, PC_B = 1536, PC_C = 4608, PC_D = 7680;
constexpr float EPS = 1e-6f;
constexpr float LOG2E = 1.4426950408889634f, LN2 = 0.6931471805599453f;
constexpr size_t MiB = 1u << 20;
constexpr size_t WS_CTL = 0, CTL_ZERO_BYTES = 1 * MiB;
constexpr size_t WS_COS64 = 1 * MiB, WS_SIN64 = 2 * MiB, WS_COS32 = 3 * MiB, WS_SIN32 = 3 * MiB + 512 * 1024;
constexpr size_t WS_PF = 4 * MiB, WS_LOGF = 4 * MiB + 256 * 1024, WS_CK = 4 * MiB + 512 * 1024, WS_LSE = 5 * MiB, WS_LSEA = 5 * MiB + 768 * 1024;
constexpr size_t WS_W0 = 8 * MiB, WS_WSTRIDE = 378 * MiB;
constexpr size_t WO_IN = 0, WO_UQ = 84 * MiB, WO_UKV = 87 * MiB, WO_O = 89 * MiB, WO_UP = 121 * MiB, WO_DN = 249 * MiB;
constexpr size_t WS_H = 764 * MiB, WS_PROJ = 828 * MiB, WS_CQ = 996 * MiB, WS_CKV = 1010 * MiB, WS_QA = 1018 * MiB, WS_KVU = 1042 * MiB, WS_KR = 1074 * MiB;
constexpr size_t WS_O = 1075 * MiB, WS_OB = 1139 * MiB, WS_X1 = 1187 * MiB, WS_U = 1315 * MiB, WS_XB = 1571 * MiB, WS_PA = 1635 * MiB, WS_WUP2 = 1667 * MiB  , WS_END = 1723 * MiB;
static_assert((size_t)NP * DM * 2 <= 84 * MiB && (size_t)S * NP * 2 <= 168 * MiB && (size_t)S * DFF * 2 <= 256 * MiB, "map");
constexpr int CW_TMO = 0, CW_CODE = 1, CW_BAR = 4096, CW_QUEUE = 16384, CW_SS = 65536, CW_KN = 61440, CW_SSQ = 131072;
constexpr int RING_OFF = 0, RING_BYTES = 131072;
constexpr int LDSCTL_OFF = RING_BYTES, MISC_OFF = LDSCTL_OFF + 320;
constexpr int LDS_BYTES = 147456;

struct Frame {
    LAS unsigned char* lds;
    volatile LAS unsigned* MISC;
    gu32* ctl;
    int tid, lane, wave, G;
};

__device__ __forceinline__ float wave_sum(float v) {
#pragma unroll
    for (int o = 1; o < 64; o <<= 1) v += __shfl_xor(v, o);
    return v;
}
__device__ __forceinline__ int opaque(int v) { asm volatile("" : "+v"(v)); return v; }
#define LFRAME Frame Fl = F; Fl.tid = opaque(F.tid); Fl.lane = Fl.tid & 63; Fl.wave = __builtin_amdgcn_readfirstlane(Fl.tid >> 6)
__device__ __forceinline__ float bf2f(unsigned short b) { return __builtin_bit_cast(float, (unsigned)b << 16); }
__device__ __forceinline__ float bflo(unsigned w) { return __builtin_bit_cast(float, w << 16); }
__device__ __forceinline__ float bfhi(unsigned w) { return __builtin_bit_cast(float, w & 0xffff0000u); }

__device__ __forceinline__ unsigned cvtpk_rne(float lo, float hi) { unsigned r; asm volatile("v_cvt_pk_bf16_f32 %0, %1, %2" : "=v"(r) : "v"(lo), "v"(hi)); return r; }
__device__ __forceinline__ void p0_item64(const float* W, int K, int N, bf16* WT, const float* gk, int item, int nblk, int lane, int ldw = 0, bool win_layout = false) {
    const int kb = item / nblk, nb = item - kb * nblk, kq = lane >> 4, c = lane & 15;
    const int kbase = 64 * kb + 16 * kq, n = 64 * nb + 4 * c; const bool ok = n < N;
    const int nbd = !win_layout ? nb : (nb <= 22 ? nb : (nb <= 166 ? nb + 1 : 23)); const int nd = 64 * nbd + 4 * c;
    f32x4 v[16];
    const float* src = W + (size_t)kbase * N + n;
#pragma unroll
    for (int i = 0; i < 16; ++i) v[i] = ok ? __builtin_nontemporal_load((const GAS f32x4*)(src + (size_t)i * N)) : (f32x4){0.f, 0.f, 0.f, 0.f};
    if (gk != nullptr) {
#pragma unroll
        for (int i = 0; i < 4; ++i) { const f32x4 g = *(const GAS f32x4*)(gk + kbase + 4 * i); v[4 * i] *= g.x; v[4 * i + 1] *= g.y; v[4 * i + 2] *= g.z; v[4 * i + 3] *= g.w; }
    }
#pragma unroll
    for (int j = 0; j < 4; ++j) {
        v4u lo, hi;
        lo.x = cvtpk_rne(v[0][j], v[1][j]); lo.y = cvtpk_rne(v[2][j], v[3][j]); lo.z = cvtpk_rne(v[4][j], v[5][j]); lo.w = cvtpk_rne(v[6][j], v[7][j]);
        hi.x = cvtpk_rne(v[8][j], v[9][j]); hi.y = cvtpk_rne(v[10][j], v[11][j]); hi.z = cvtpk_rne(v[12][j], v[13][j]); hi.w = cvtpk_rne(v[14][j], v[15][j]);
        bf16* dst = WT + (size_t)(nd + j) * (ldw ? ldw : K) + kbase;
        *(GAS v4u*)dst = lo; *(GAS v4u*)(dst + 8) = hi;
    }
}
__device__ __forceinline__ void sincos_d(double a, float& sn, float& cs) {
    const double k = __builtin_rint(a * 0.15915494309189535);
    double r = __builtin_fma(-k, 6.283185307179586, a); r = __builtin_fma(-k, 2.4492935982947064e-16, r);
    const double q = __builtin_rint(r * 0.6366197723675814);
    double x = __builtin_fma(-q, 1.5707963267948966, r); x = __builtin_fma(-q, 6.123233995736766e-17, x);
    const double x2 = x * x;
    double sp = 1.0 / 6227020800.0; sp = sp * x2 - 1.0 / 39916800.0; sp = sp * x2 + 1.0 / 362880.0; sp = sp * x2 - 1.0 / 5040.0; sp = sp * x2 + 1.0 / 120.0; sp = sp * x2 - 1.0 / 6.0; sp = sp * x2 * x + x;
    double cp = -1.0 / 87178291200.0; cp = cp * x2 + 1.0 / 479001600.0; cp = cp * x2 - 1.0 / 3628800.0; cp = cp * x2 + 1.0 / 40320.0; cp = cp * x2 - 1.0 / 720.0; cp = cp * x2 + 1.0 / 24.0; cp = cp * x2 - 0.5; cp = cp * x2 + 1.0;
    const int qi = ((int)q) & 3;
    const double s = (qi == 0) ? sp : (qi == 1) ? cp : (qi == 2) ? -sp : -cp;
    const double c = (qi == 0) ? cp : (qi == 1) ? -sp : (qi == 2) ? -cp : sp;
    sn = (float)s; cs = (float)c;
}
__device__ __forceinline__ double powi_d(double c, int i) { double r = 1.0, b = c; for (int e = 0; e < 5; ++e) { if (i & (1 << e)) r *= b; b *= b; } return r; }

struct Ptrs {
    const float *x, *g_attn, *w_in, *g_q, *g_kv, *w_uq, *w_uk, *w_uv, *b_f, *g_out, *w_o, *g_mlp, *w_up, *w_down, *g_final;
    float* out; unsigned char* ws;
};
__device__ __forceinline__ bf16* wsb(const Ptrs& P, size_t off) { return (bf16*)(P.ws + off); }
__device__ __forceinline__ float* wsf(const Ptrs& P, size_t off) { return (float*)(P.ws + off); }

__device__ __forceinline__ void p0_prologue(Frame& F, const Ptrs& P, int lsel, int part) {
    const int gw = blockIdx.x * NWAVES + F.wave, NGW = F.G * NWAVES;
    constexpr int I_IN = (DM / 64) * (NP / 64), I_UQ = (QLR / 64) * (NQA / 64), I_UK = (KVLR / 64) * (GW / 64), I_O = (DM / 64) * (DM / 64), I_UP = (DM / 64) * (DFF / 64), I_DN = (DFF / 64) * (DM / 64);
    constexpr int PER = I_IN + I_UQ + 2 * I_UK + I_O + I_UP + I_DN;
    constexpr int P0N = I_IN + I_UQ + 2 * I_UK;
    const int lo_ = (part == 0) ? 0 : (part == 1) ? P0N : (part == 2) ? P0N + I_O : P0N + I_O + I_UP, hi_ = (part == 0) ? P0N : (part == 1) ? P0N + I_O : (part == 2) ? P0N + I_O + I_UP : PER;
    for (int it = lo_ + gw; it < hi_; it += NGW) {
        const int l = lsel; int r = it; const size_t wb = WS_W0 + (size_t)l * WS_WSTRIDE;
        if (r < I_IN) { p0_item64(P.w_in + (size_t)l * DM * INC, DM, INC, wsb(P, wb + WO_IN), P.g_attn + (size_t)l * DM, r, NP / 64, F.lane, 0, true); continue; } r -= I_IN;
        if (r < I_UQ) { p0_item64(P.w_uq + (size_t)l * QLR * NQA, QLR, NQA, wsb(P, WS_WUP2 + (size_t)l * 28 * MiB), P.g_q + (size_t)l * QLR, r, NQA / 64, F.lane, DM); continue; } r -= I_UQ;
        if (r < I_UK) { p0_item64(P.w_uk + (size_t)l * KVLR * GW, KVLR, GW, wsb(P, WS_WUP2 + (size_t)l * 28 * MiB + 12 * MiB), P.g_kv + (size_t)l * KVLR, r, GW / 64, F.lane, DM); continue; } r -= I_UK;
        if (r < I_UK) { p0_item64(P.w_uv + (size_t)l * KVLR * GW, KVLR, GW, wsb(P, WS_WUP2 + (size_t)l * 28 * MiB + 12 * MiB) + (size_t)GW * DM, P.g_kv + (size_t)l * KVLR, r, GW / 64, F.lane, DM); continue; } r -= I_UK;
        if (r < I_O) { p0_item64(P.w_o + (size_t)l * DM * DM, DM, DM, wsb(P, wb + WO_O), nullptr, r, DM / 64, F.lane); continue; } r -= I_O;
        if (r < I_UP) { p0_item64(P.w_up + (size_t)l * DM * DFF, DM, DFF, wsb(P, wb + WO_UP), P.g_mlp + (size_t)l * DM, r, DFF / 64, F.lane); continue; } r -= I_UP;
        p0_item64(P.w_down + (size_t)l * DFF * DM, DFF, DM, wsb(P, wb + WO_DN), nullptr, r, DM / 64, F.lane);
    }
    if (lsel == 0 && part == 0) {
    { float* ss0 = (float*)(F.ctl + CW_SS); bf16* XB = wsb(P, WS_XB);
      for (int m = gw; m < S; m += NGW) {
        const GAS f32x4* xr = (const GAS f32x4*)(P.x + (size_t)m * DM) + F.lane; GAS unsigned long long* o8 = (GAS unsigned long long*)(XB + (size_t)m * DM) + F.lane; float sq = 0.f;
#pragma unroll
        for (int j = 0; j < 16; ++j) { const f32x4 v = xr[64 * j]; sq += (v.x * v.x + v.y * v.y) + (v.z * v.z + v.w * v.w); o8[64 * j] = (unsigned long long)cvtpk_rne(v.x, v.y) | ((unsigned long long)cvtpk_rne(v.z, v.w) << 32); }
        sq = wave_sum(sq); if (F.lane == 0) ss0[m] = sq; } }
    const int gt = blockIdx.x * (NWAVES * 64) + F.tid, NGT = F.G * NWAVES * 64;
    for (int e = gt; e < S * 48; e += NGT) {
        const int pos = e / 48, j = e % 48;
        float sn, cs;
        if (j < 32) { const double inv = powi_d(0.6636012376960885, j); sincos_d((double)pos * inv, sn, cs); wsf(P, WS_COS64)[pos * 32 + j] = cs; wsf(P, WS_SIN64)[pos * 32 + j] = sn; }
        else { const int i = j - 32; const double inv = powi_d(0.44036660267178046, i); sincos_d((double)pos * inv, sn, cs); wsf(P, WS_COS32)[pos * 16 + i] = cs; wsf(P, WS_SIN32)[pos * 16 + i] = sn; }
    }
    }
}

__device__ __forceinline__ void conv_range(Frame& F, const Ptrs& P, int lsel, int it_lo, int it_hi) {
    constexpr int I_IN = (DM / 64) * (NP / 64), I_UQ = (QLR / 64) * (NQA / 64), I_UK = (KVLR / 64) * (GW / 64), I_O = (DM / 64) * (DM / 64), I_UP = (DM / 64) * (DFF / 64);
    const int l = lsel; const size_t wb = WS_W0 + (size_t)l * WS_WSTRIDE;
    for (int it = it_lo + F.wave; it < it_hi; it += NWAVES) {
        int r = it;
        if (r < I_IN) { p0_item64(P.w_in + (size_t)l * DM * INC, DM, INC, wsb(P, wb + WO_IN), P.g_attn + (size_t)l * DM, r, NP / 64, F.lane, 0, true); continue; } r -= I_IN;
        if (r < I_UQ) { p0_item64(P.w_uq + (size_t)l * QLR * NQA, QLR, NQA, wsb(P, WS_WUP2 + (size_t)l * 28 * MiB), P.g_q + (size_t)l * QLR, r, NQA / 64, F.lane, DM); continue; } r -= I_UQ;
        if (r < I_UK) { p0_item64(P.w_uk + (size_t)l * KVLR * GW, KVLR, GW, wsb(P, WS_WUP2 + (size_t)l * 28 * MiB + 12 * MiB), P.g_kv + (size_t)l * KVLR, r, GW / 64, F.lane, DM); continue; } r -= I_UK;
        if (r < I_UK) { p0_item64(P.w_uv + (size_t)l * KVLR * GW, KVLR, GW, wsb(P, WS_WUP2 + (size_t)l * 28 * MiB + 12 * MiB) + (size_t)GW * DM, P.g_kv + (size_t)l * KVLR, r, GW / 64, F.lane, DM); continue; } r -= I_UK;
        if (r < I_O) { p0_item64(P.w_o + (size_t)l * DM * DM, DM, DM, wsb(P, wb + WO_O), nullptr, r, DM / 64, F.lane); continue; } r -= I_O;
        if (r < I_UP) { p0_item64(P.w_up + (size_t)l * DM * DFF, DM, DFF, wsb(P, wb + WO_UP), P.g_mlp + (size_t)l * DM, r, DFF / 64, F.lane); continue; } r -= I_UP;
        p0_item64(P.w_down + (size_t)l * DFF * DM, DFF, DM, wsb(P, wb + WO_DN), nullptr, r, DM / 64, F.lane);
    }
}

template <bool F32OUT>
__device__ __forceinline__ void rms_rows(Frame& F, const float* X, const float* g, bf16* ob, float* of) {
    const int gw = blockIdx.x * NWAVES + F.wave, NGW = F.G * NWAVES;
    for (int m = gw; m < S; m += NGW) {
        const GAS f32x4* xr = (const GAS f32x4*)(X + (size_t)m * DM) + F.lane;
        f32x4 v[16]; float s = 0.f;
#pragma unroll
        for (int j = 0; j < 16; ++j) { v[j] = xr[64 * j]; s += (v[j].x * v[j].x + v[j].y * v[j].y) + (v[j].z * v[j].z + v[j].w * v[j].w); }
        const float rstd = 1.f / sqrtf(wave_sum(s) * (1.f / DM) + EPS);
        const GAS f32x4* gr = (const GAS f32x4*)g + F.lane;
        if (F32OUT) { GAS f32x4* o = (GAS f32x4*)(of + (size_t)m * DM) + F.lane;
#pragma unroll
            for (int j = 0; j < 16; ++j) { const f32x4 gg = gr[64 * j]; o[64 * j] = v[j] * rstd * gg; } }
        else { GAS unsigned long long* o8 = (GAS unsigned long long*)(ob + (size_t)m * DM) + F.lane;
#pragma unroll
            for (int j = 0; j < 16; ++j) { const f32x4 gg = gr[64 * j]; const f32x4 y = v[j] * rstd * gg;
                o8[64 * j] = (unsigned long long)pk2(y.x, y.y) | ((unsigned long long)pk2(y.z, y.w) << 32); } }
    }
}

__device__ __forceinline__ void postproj_rows(Frame& F, const Ptrs& P, int l, int b0, int nb_) {
    const int gw = ((int)blockIdx.x - b0) * NWAVES + F.wave, NGW = nb_ * NWAVES, lane = F.lane;
    bf16* PROJ = wsb(P, WS_PROJ); bf16* CQ = wsb(P, WS_CQ); bf16* CKV = wsb(P, WS_CKV); bf16* KR = wsb(P, WS_KR);
    const float* gq = P.g_q + l * QLR; const float* gkv = P.g_kv + l * KVLR; const float* bfp = P.b_f + l * NH;
    const float* C64 = wsf(P, WS_COS64); const float* S64 = wsf(P, WS_SIN64); const float* C32 = wsf(P, WS_COS32); const float* S32 = wsf(P, WS_SIN32);
    float knmax[2] = {0.f, 0.f};
    for (int m = gw; m < S; m += NGW) {
        bf16* prow = PROJ + (size_t)m * NP;
        if (lane < 32) {
            const float t1 = bf2f(prow[PC_KR + lane]), t2 = bf2f(prow[PC_KR + 32 + lane]); const float c = C64[m * 32 + lane], sn = S64[m * 32 + lane];
            KR[(size_t)m * 64 + lane] = (bf16)f2bf(t1 * c - t2 * sn); KR[(size_t)m * 64 + 32 + lane] = (bf16)f2bf(t1 * sn + t2 * c);
        }
        {
            const int chunk = lane >> 2, part = lane & 3; bf16* cp = prow + PC_B + (chunk >> 3) * GW + (chunk & 7) * HD + 4 * part;
            const unsigned long long w1 = *(const GAS unsigned long long*)cp, w2 = *(const GAS unsigned long long*)(cp + 16);
            const f32x4 c = *(const GAS f32x4*)(C32 + (size_t)m * 16 + 4 * part), sn = *(const GAS f32x4*)(S32 + (size_t)m * 16 + 4 * part);
            const float a0 = bflo((unsigned)w1), a1 = bfhi((unsigned)w1), a2 = bflo((unsigned)(w1 >> 32)), a3 = bfhi((unsigned)(w1 >> 32));
            const float b0 = bflo((unsigned)w2), b1 = bfhi((unsigned)w2), b2 = bflo((unsigned)(w2 >> 32)), b3 = bfhi((unsigned)(w2 >> 32));
            *(GAS unsigned long long*)cp = (unsigned long long)pk2(a0 * c.x - b0 * sn.x, a1 * c.y - b1 * sn.y) | ((unsigned long long)pk2(a2 * c.z - b2 * sn.z, a3 * c.w - b3 * sn.w) << 32);
            *(GAS unsigned long long*)(cp + 16) = (unsigned long long)pk2(a0 * sn.x + b0 * c.x, a1 * sn.y + b1 * c.y) | ((unsigned long long)pk2(a2 * sn.z + b2 * c.z, a3 * sn.w + b3 * c.w) << 32);
        }
        {
#pragma unroll
            for (int c = 0; c < 2; ++c) { const v4u w = *(const GAS v4u*)(prow + PC_D + GW + c * 512 + 8 * lane);
                float sq = bflo(w.x) * bflo(w.x) + bfhi(w.x) * bfhi(w.x) + bflo(w.y) * bflo(w.y) + bfhi(w.y) * bfhi(w.y) + bflo(w.z) * bflo(w.z) + bfhi(w.z) * bfhi(w.z) + bflo(w.w) * bflo(w.w) + bfhi(w.w) * bfhi(w.w);
                sq += __shfl_xor(sq, 1); sq += __shfl_xor(sq, 2); sq += __shfl_xor(sq, 4); sq += __shfl_xor(sq, 8);
                knmax[c] = fmaxf(knmax[c], sq); }
        }
    }
    {
        LAS float* red = (LAS float*)(F.lds + RING_OFF);
        if ((lane & 15) == 0) { red[F.wave * 8 + (lane >> 4)] = knmax[0]; red[F.wave * 8 + 4 + (lane >> 4)] = knmax[1]; }
        __syncthreads();
        if (F.tid < NH) { float mx = 0.f;
#pragma unroll
            for (int w = 0; w < NWAVES; ++w) mx = fmaxf(mx, red[w * 8 + F.tid]);
            __hip_atomic_fetch_max(F.ctl + CW_KN + 16 * (l & 1) + F.tid, __builtin_bit_cast(unsigned, mx), __ATOMIC_RELAXED, __HIP_MEMORY_SCOPE_AGENT); }
        __syncthreads();
    }
}

__device__ __forceinline__ void cumsum_head(Frame& F, const Ptrs& P, int h, int l) {
    const float* PFp = wsf(P, WS_PF); const float bfh = P.b_f[l * NH + h]; float* CK = wsf(P, WS_CK) + (size_t)h * S;
    LAS float* wt = (LAS float*)(F.lds + RING_OFF);
    float v[16]; float run = 0.f;
#pragma unroll
    for (int j = 0; j < 16; ++j) { const float z = PFp[(size_t)(16 * F.tid + j) * 8 + h] + bfh; run += fminf(z, 0.f) - log1pf(expf(-fabsf(z))); v[j] = run; }
    float inc = run;
#pragma unroll
    for (int o = 1; o < 64; o <<= 1) { const float t = __shfl_up(inc, o); if (F.lane >= o) inc += t; }
    if (F.lane == 63) wt[F.wave] = inc;
    __syncthreads();
    float base = inc - run;
    for (int w = 0; w < F.wave; ++w) base += wt[w];
#pragma unroll
    for (int j = 0; j < 16; ++j) CK[16 * F.tid + j] = base + v[j];
    __syncthreads();
}


namespace fa {
typedef short bf16x8 __attribute__((ext_vector_type(8)));
typedef short s16x4 __attribute__((ext_vector_type(4)));
typedef float f32x16 __attribute__((ext_vector_type(16)));
typedef float f32x4 __attribute__((ext_vector_type(4)));
typedef unsigned u32x4 __attribute__((ext_vector_type(4)));
constexpr int L_V = 0, L_K = 32768, L_KR = 65536, L_WS = 81920, L_BIAS = 83968, L_FLAG = 84480, L_ITEM = 84608;
constexpr int SHM = 16384;
#define FA_LP(T, off) ((LAS T*)(lds + (off)))
__device__ __forceinline__ int kswz(int row, int colB) { return row * 256 + (colB ^ ((row & 7) << 4)); }
__device__ __forceinline__ int krswz(int row, int colB) { return row * 128 + (colB ^ ((row & 7) << 4)); }
__device__ __forceinline__ int v_st(int k, int c) { const int kk = (k & ~0xC) | ((k & 4) << 1) | ((k & 8) >> 1); return ((kk >> 3) * 4 + (c >> 5)) * 512 + ((kk & 7) * 32 + (c & 31)) * 2; }
__device__ __forceinline__ int v_rd_base(int lane) { return ((lane & 3) << 3) | (((lane >> 2) & 3) << 6) | (((lane >> 4) & 1) << 5) | (((lane >> 5) & 1) << 8); }
constexpr int v_rd_off(int d0, int ks, int half) { return d0 * 512 + ks * 4096 + half * 2048; }
__device__ __forceinline__ int crow(int r, int hi) { return (r & 3) + 8 * (r >> 2) + 4 * hi; }
__device__ __forceinline__ unsigned cvtpk(float lo, float hi) { unsigned r; asm volatile("v_cvt_pk_bf16_f32 %0, %1, %2" : "=v"(r) : "v"(lo), "v"(hi)); return r; }
__device__ __forceinline__ float xsum(float v) { auto rr = __builtin_amdgcn_permlane32_swap(__float_as_uint(v), __float_as_uint(v), false, false); return __uint_as_float(rr[0]) + __uint_as_float(rr[1]); }
__device__ __forceinline__ float xmax(float v) { auto rr = __builtin_amdgcn_permlane32_swap(__float_as_uint(v), __float_as_uint(v), false, false); return fmaxf(__uint_as_float(rr[0]), __uint_as_float(rr[1])); }
#define FA_SBAR() __builtin_amdgcn_sched_barrier(0)

struct UnitRef {
    const bf16* Q; int qp;
    const bf16* K; int kp;
    const bf16* V; int vp;
    const bf16* KR;
    const float* CK;
    const float* COS; const float* SIN;
    bf16* O; int op;
    float* LSE; int lp;
    int P0;
    int jlo, jhi;
    float kn2;
};

template <int VAR>
__device__ __forceinline__ void attn_unit(LAS unsigned char* lds, const UnitRef& U, int tid) {
    constexpr int NQ = (VAR == 0) ? 12 : 8;
    constexpr float SCALE = (VAR == 0) ? 0.07216878364870323f : 0.08838834764831845f;
    constexpr float C2 = SCALE * 1.4426950408889634f;
    constexpr float THR2 = 8.f * 1.4426950408889634f;
    const int wid = __builtin_amdgcn_readfirstlane(tid >> 6), lane = tid & 63, r32 = lane & 31, hi = lane >> 5;
    const int W = (VAR == 1) ? 129 : 0x40000000;
    const int P0 = U.P0;
    const int j_lo = U.jlo, j_hi = U.jhi;
    const int qlo = P0 + wid * 32;
    const int qm = qlo + r32 - 4 * hi - (VAR == 2 ? 1 : 0);
    bf16x8 qr[NQ];
    { const bf16* qrow = U.Q + (size_t)(wid * 32 + r32) * U.qp + hi * 8;
#pragma unroll
      for (int d0 = 0; d0 < 8; ++d0) qr[d0] = *(const GAS bf16x8*)(qrow + d0 * 16);
      if constexpr (VAR == 0) {
          bf16x8 f[4];
#pragma unroll
          for (int d = 0; d < 4; ++d) f[d] = *(const GAS bf16x8*)(qrow + 128 + d * 16);
          const int pos = qlo + r32;
#pragma unroll
          for (int d = 0; d < 2; ++d) {
              const f32x4 c0 = *(const GAS f32x4*)(U.COS + (size_t)pos * 32 + d * 16 + hi * 8), c1 = *(const GAS f32x4*)(U.COS + (size_t)pos * 32 + d * 16 + hi * 8 + 4);
              const f32x4 s0 = *(const GAS f32x4*)(U.SIN + (size_t)pos * 32 + d * 16 + hi * 8), s1 = *(const GAS f32x4*)(U.SIN + (size_t)pos * 32 + d * 16 + hi * 8 + 4);
              float n1[8], n2[8];
#pragma unroll
              for (int j = 0; j < 8; ++j) { const float t1 = bf2f((unsigned short)f[d][j]), t2 = bf2f((unsigned short)f[d + 2][j]); const float c = j < 4 ? c0[j & 3] : c1[j & 3], s = j < 4 ? s0[j & 3] : s1[j & 3];
                  n1[j] = t1 * c - t2 * s; n2[j] = t1 * s + t2 * c; }
              u32x4 w1 = {pk2(n1[0], n1[1]), pk2(n1[2], n1[3]), pk2(n1[4], n1[5]), pk2(n1[6], n1[7])}, w2 = {pk2(n2[0], n2[1]), pk2(n2[2], n2[3]), pk2(n2[4], n2[5]), pk2(n2[6], n2[7])};
              qr[8 + d] = __builtin_bit_cast(bf16x8, w1); qr[10 + d] = __builtin_bit_cast(bf16x8, w2);
          }
      }
    }
    float qb2 = 0.f;
    if constexpr (VAR == 3) { float sq = 0.f;
#pragma unroll
        for (int d0 = 0; d0 < 8; ++d0)
#pragma unroll
            for (int j = 0; j < 8; ++j) { const float v = bf2f((unsigned short)qr[d0][j]); sq += v * v; }
        sq = xsum(sq); qb2 = sqrtf(sq * U.kn2) * C2; }
    unsigned dk, dv, dkr = 0;
    { const int krow = 4 * wid + (lane >> 4); dk = (unsigned)(krow * U.kp + (((lane & 15) ^ (krow & 7)) * 8)) * 2u;
      const int kk = ((wid >> 1) << 3) | ((lane & 31) >> 2); const int kv = (kk & ~0xC) | ((kk & 4) << 1) | ((kk & 8) >> 1); const int cv = (2 * (wid & 1) + (lane >> 5)) * 32 + (lane & 3) * 8;
      dv = (unsigned)(kv * U.vp + cv) * 2u;
      if constexpr (VAR == 0) { const int rr = 8 * wid + (lane >> 3); dkr = (unsigned)(rr * 64 + (((lane & 7) ^ (rr & 7)) * 8)) * 2u; } }
    float st_b = 0.f;
    float cref = 0.f; if constexpr (VAR == 3) cref = U.CK[P0];
#define FA_SLOAD(kb, bf) do { const char* kb_ = (const char*)(U.K + (size_t)(kb) * U.kp); const char* vb_ = (const char*)(U.V + (size_t)(kb) * U.vp); \
        __builtin_amdgcn_global_load_lds((const unsigned*)(kb_ + dk), FA_LP(unsigned, L_K + (bf) * SHM + wid * 1024), 16, 0, 0); \
        __builtin_amdgcn_global_load_lds((const unsigned*)(kb_ + (size_t)64 * U.kp + dk), FA_LP(unsigned, L_K + (bf) * SHM + 8192 + wid * 1024), 16, 0, 0); \
        __builtin_amdgcn_global_load_lds((const unsigned*)(vb_ + dv), FA_LP(unsigned, L_V + (bf) * SHM + wid * 1024), 16, 0, 0); \
        __builtin_amdgcn_global_load_lds((const unsigned*)(vb_ + (size_t)64 * U.vp + dv), FA_LP(unsigned, L_V + (bf) * SHM + 8192 + wid * 1024), 16, 0, 0); \
        if constexpr (VAR == 0) __builtin_amdgcn_global_load_lds((const unsigned*)((const char*)(U.KR + (size_t)(kb) * 64) + dkr), FA_LP(unsigned, L_KR + (bf) * 8192 + wid * 1024), 16, 0, 0); \
        if constexpr (VAR == 3) { st_b = U.CK[(kb) + lane]; } } while (0)
#define FA_SWRITE(bf) do { \
        if constexpr (VAR == 3) { if (tid < 64) *FA_LP(float, L_BIAS + (bf) * 256 + tid * 4) = (cref - st_b) * 1.4426950408889634f; } } while (0)
    LAS float* li_l = FA_LP(float, L_WS + wid * 256); LAS float* al_l = li_l + 32;
    const unsigned vb0 = (unsigned)(uintptr_t)(lds + L_V) + v_rd_base(lane);
    unsigned kb4[4];
#pragma unroll
    for (int dd = 0; dd < 4; ++dd) kb4[dd] = (unsigned)(uintptr_t)(lds + L_K) + kswz(r32, (dd * 16 + hi * 8) * 2);
    unsigned krb4[4];
    if constexpr (VAR == 0) {
#pragma unroll
        for (int dd = 0; dd < 4; ++dd) krb4[dd] = (unsigned)(uintptr_t)(lds + L_KR) + krswz(r32, (dd * 16 + hi * 8) * 2);
    }
    float m2 = -1e30f, l_reg = 0.f, R2 = 0.f;
    f32x16 o[4];
#pragma unroll
    for (int d = 0; d < 4; ++d)
#pragma unroll
        for (int r = 0; r < 16; ++r) o[d][r] = 0.f;
    bool wdone = false;
    FA_SLOAD((j_hi - 1) * 64, 0);
    asm volatile("s_waitcnt vmcnt(0)" ::: "memory");
    FA_SWRITE(0);
    __syncthreads();

#define FA_TRRD(dst, off) asm volatile("ds_read_b64_tr_b16 %0, %1 offset:%2" : "=&v"(dst) : "v"(vb0), "i"(off) : "memory")
#define FA_VRD8(S, BUF, d0) do { constexpr int b_ = (BUF) * SHM + v_rd_off(d0, 0, 0); \
        FA_TRRD(S##l0, b_); FA_TRRD(S##h0, b_ + 2048); FA_TRRD(S##l1, b_ + 4096); FA_TRRD(S##h1, b_ + 6144); FA_TRRD(S##l2, b_ + 8192); FA_TRRD(S##h2, b_ + 10240); FA_TRRD(S##l3, b_ + 12288); FA_TRRD(S##h3, b_ + 14336); } while (0)
#define FA_PVMMA(S, d0) do { \
        o[d0] = __builtin_amdgcn_mfma_f32_32x32x16_bf16(pa0, (bf16x8){S##l0[0], S##l0[1], S##l0[2], S##l0[3], S##h0[0], S##h0[1], S##h0[2], S##h0[3]}, o[d0], 0, 0, 0); \
        o[d0] = __builtin_amdgcn_mfma_f32_32x32x16_bf16(pa1, (bf16x8){S##l1[0], S##l1[1], S##l1[2], S##l1[3], S##h1[0], S##h1[1], S##h1[2], S##h1[3]}, o[d0], 0, 0, 0); \
        o[d0] = __builtin_amdgcn_mfma_f32_32x32x16_bf16(pa2, (bf16x8){S##l2[0], S##l2[1], S##l2[2], S##l2[3], S##h2[0], S##h2[1], S##h2[2], S##h2[3]}, o[d0], 0, 0, 0); \
        o[d0] = __builtin_amdgcn_mfma_f32_32x32x16_bf16(pa3, (bf16x8){S##l3[0], S##l3[1], S##l3[2], S##l3[3], S##h3[0], S##h3[1], S##h3[2], S##h3[3]}, o[d0], 0, 0, 0); } while (0)
#define FA_LGKM(n) asm volatile("s_waitcnt lgkmcnt(" #n ")" ::: "memory")
#define FA_PV(BUF) do { s16x4 Xl0, Xl1, Xl2, Xl3, Xh0, Xh1, Xh2, Xh3, Yl0, Yl1, Yl2, Yl3, Yh0, Yh1, Yh2, Yh3; \
        FA_VRD8(X, BUF, 0); FA_VRD8(Y, BUF, 1); FA_LGKM(8); FA_SBAR(); FA_PVMMA(X, 0); FA_SBAR(); \
        FA_VRD8(X, BUF, 2); FA_LGKM(8); FA_SBAR(); FA_PVMMA(Y, 1); FA_SBAR(); \
        FA_VRD8(Y, BUF, 3); FA_LGKM(8); FA_SBAR(); FA_PVMMA(X, 2); FA_SBAR(); \
        FA_LGKM(0); FA_SBAR(); FA_PVMMA(Y, 3); } while (0)
#define FA_VRD4(S, BUF, d0, ks) do { constexpr int b_ = (BUF) * SHM + v_rd_off(d0, ks, 0); FA_TRRD(S##l0, b_); FA_TRRD(S##h0, b_ + 2048); FA_TRRD(S##l1, b_ + 4096); FA_TRRD(S##h1, b_ + 6144); } while (0)
#define FA_MMA2(S, d0, PA, PB) do { \
        o[d0] = __builtin_amdgcn_mfma_f32_32x32x16_bf16(PA, (bf16x8){S##l0[0], S##l0[1], S##l0[2], S##l0[3], S##h0[0], S##h0[1], S##h0[2], S##h0[3]}, o[d0], 0, 0, 0); \
        o[d0] = __builtin_amdgcn_mfma_f32_32x32x16_bf16(PB, (bf16x8){S##l1[0], S##l1[1], S##l1[2], S##l1[3], S##h1[0], S##h1[1], S##h1[2], S##h1[3]}, o[d0], 0, 0, 0); } while (0)
#define FA_EXPS(P, i0) do { _Pragma("unroll") for (int r_ = (i0); r_ < (i0) + 4; ++r_) { if constexpr (VAR == 3) P[r_] = __builtin_amdgcn_exp2f(P[r_] - m2); else P[r_] = __builtin_amdgcn_exp2f(fmaf(P[r_], C2, -m2)); ps += P[r_]; } } while (0)
#define FA_PV2(BUF) do { s16x4 Al0, Ah0, Al1, Ah1, Bl0, Bh0, Bl1, Bh1, Cl0, Ch0, Cl1, Ch1, Dl0, Dh0, Dl1, Dh1; \
        FA_VRD4(A, BUF, 0, 0); FA_VRD4(B, BUF, 1, 0); FA_VRD4(C, BUF, 2, 0); FA_VRD4(D, BUF, 3, 0); \
        FA_LGKM(12); FA_SBAR(); FA_MMA2(A, 0, pa0, pa1); FA_SBAR(); FA_EXPS(p1, 0); FA_VRD4(A, BUF, 0, 2); \
        FA_LGKM(12); FA_SBAR(); FA_MMA2(B, 1, pa0, pa1); FA_SBAR(); FA_EXPS(p1, 4); FA_PK4(p1, 0, pa2); FA_VRD4(B, BUF, 1, 2); \
        FA_LGKM(12); FA_SBAR(); FA_MMA2(C, 2, pa0, pa1); FA_SBAR(); FA_EXPS(p1, 8); FA_VRD4(C, BUF, 2, 2); \
        FA_LGKM(12); FA_SBAR(); FA_MMA2(D, 3, pa0, pa1); FA_SBAR(); FA_EXPS(p1, 12); FA_PK4(p1, 8, pa3); FA_VRD4(D, BUF, 3, 2); \
        FA_LGKM(12); FA_SBAR(); FA_MMA2(A, 0, pa2, pa3); FA_SBAR(); \
        FA_LGKM(8); FA_SBAR(); FA_MMA2(B, 1, pa2, pa3); FA_SBAR(); \
        FA_LGKM(4); FA_SBAR(); FA_MMA2(C, 2, pa2, pa3); FA_SBAR(); \
        FA_LGKM(0); FA_SBAR(); FA_MMA2(D, 3, pa2, pa3); } while (0)
#define FA_KRD(dst, areg, off) asm volatile("ds_read_b128 %0, %1 offset:%2" : "=&v"(dst) : "v"(areg), "i"(off) : "memory")
#define FA_KPAIR(A_, B_, BUF, d0) do { if constexpr ((d0) < 8) { FA_KRD(A_, kb4[(d0) & 3], ((d0) >> 2) * 128 + (BUF) * SHM); FA_KRD(B_, kb4[(d0) & 3], ((d0) >> 2) * 128 + (BUF) * SHM + 32 * 256); } \
        else { FA_KRD(A_, krb4[((d0) - 8) & 3], (BUF) * 8192); FA_KRD(B_, krb4[((d0) - 8) & 3], (BUF) * 8192 + 32 * 128); } } while (0)
#define FA_QKMMA(A_, B_, d0) do { p0 = __builtin_amdgcn_mfma_f32_32x32x16_bf16(A_, qr[d0], p0, 0, 0, 0); p1 = __builtin_amdgcn_mfma_f32_32x32x16_bf16(B_, qr[d0], p1, 0, 0, 0); } while (0)
#define FA_QKSTEP(CA, CB, NA, NB, BUF, d0) do { if constexpr ((d0) + 1 < NQ) { FA_KPAIR(NA, NB, BUF, (d0) + 1); FA_LGKM(2); } else { FA_LGKM(0); } FA_SBAR(); FA_QKMMA(CA, CB, d0); FA_SBAR(); } while (0)
#define FA_QK(BUF) do { bf16x8 ea, eb, fa_, fb; FA_KPAIR(ea, eb, BUF, 0); \
        FA_QKSTEP(ea, eb, fa_, fb, BUF, 0); FA_QKSTEP(fa_, fb, ea, eb, BUF, 1); FA_QKSTEP(ea, eb, fa_, fb, BUF, 2); FA_QKSTEP(fa_, fb, ea, eb, BUF, 3); \
        FA_QKSTEP(ea, eb, fa_, fb, BUF, 4); FA_QKSTEP(fa_, fb, ea, eb, BUF, 5); FA_QKSTEP(ea, eb, fa_, fb, BUF, 6); FA_QKSTEP(fa_, fb, ea, eb, BUF, 7); \
        if constexpr (NQ == 12) { FA_QKSTEP(ea, eb, fa_, fb, BUF, 8); FA_QKSTEP(fa_, fb, ea, eb, BUF, 9); FA_QKSTEP(ea, eb, fa_, fb, BUF, 10); FA_QKSTEP(fa_, fb, ea, eb, BUF, 11); } } while (0)
#define FA_PK4(P, B_, OUT) do { unsigned a0 = cvtpk(P[B_ + 0], P[B_ + 1]), a1 = cvtpk(P[B_ + 2], P[B_ + 3]); unsigned b0 = cvtpk(P[B_ + 4], P[B_ + 5]), b1 = cvtpk(P[B_ + 6], P[B_ + 7]); \
        auto r0 = __builtin_amdgcn_permlane32_swap(a0, b0, false, false); auto r1 = __builtin_amdgcn_permlane32_swap(a1, b1, false, false); \
        u32x4 w = {r0[0], r1[0], r0[1], r1[1]}; OUT = __builtin_bit_cast(bf16x8, w); } while (0)

#define FA_STEP(BUF, jt) do { \
        const int kb = (jt) * 64; const bool more = (jt) > j_lo; \
        if (more) FA_SLOAD(kb - 64, (BUF) ^ 1); \
        const bool act = !wdone && (kb <= qlo + 31) && (kb + 63 >= qlo - W + 1); \
        if (act) { \
            f32x16 p0, p1; \
            _Pragma("unroll") for (int r = 0; r < 16; ++r) { p0[r] = 0.f; p1[r] = 0.f; } \
            FA_QK(BUF); \
            bf16x8 pa0, pa1, pa2, pa3; \
            const int dq = qm - kb; \
            const bool needmask = (kb + 63 >= qlo) || (kb <= qlo + 31 - W); \
            if constexpr (VAR == 2) { \
                  \
                _Pragma("unroll") for (int r = 0; r < 16; ++r) { p0[r] = fminf(p0[r] * C2, 100.f); p1[r] = fminf(p1[r] * C2, 100.f); } \
                f32x16 x0, x1; \
                _Pragma("unroll") for (int r = 0; r < 16; ++r) { x0[r] = __builtin_amdgcn_logf(1.f + __builtin_amdgcn_exp2f(p0[r])); x1[r] = __builtin_amdgcn_logf(1.f + __builtin_amdgcn_exp2f(p1[r])); } \
                if (needmask) { _Pragma("unroll") for (int r = 0; r < 16; ++r) { const int c = (r & 3) + 8 * (r >> 2); \
                    if (dq - c < 0) { x0[r] = 0.f; p0[r] = -__builtin_inff(); } if (dq - c - 32 < 0) { x1[r] = 0.f; p1[r] = -__builtin_inff(); } } } \
                float S0[4], S1[4], C0[4], C1[4]; \
                _Pragma("unroll") for (int i = 0; i < 4; ++i) { S0[i] = (x0[4 * i] + x0[4 * i + 1]) + (x0[4 * i + 2] + x0[4 * i + 3]); S1[i] = (x1[4 * i] + x1[4 * i + 1]) + (x1[4 * i + 2] + x1[4 * i + 3]); \
                    C0[i] = xsum(S0[i]); C1[i] = xsum(S1[i]); } \
                const float fsel = hi ? 0.f : 1.f; \
                float E1[4], E0[4]; E1[3] = 0.f; E1[2] = C1[3]; E1[1] = E1[2] + C1[2]; E1[0] = E1[1] + C1[1]; const float T1 = E1[0] + C1[0]; \
                E0[3] = 0.f; E0[2] = C0[3]; E0[1] = E0[2] + C0[2]; E0[0] = E0[1] + C0[1]; const float T0 = E0[0] + C0[0]; \
                _Pragma("unroll") for (int i = 0; i < 4; ++i) { \
                    float ag = R2 + E1[i] + fsel * (C1[i] - S1[i]); \
                    float a3 = ag, a2 = a3 + x1[4 * i + 3], a1 = a2 + x1[4 * i + 2], a0 = a1 + x1[4 * i + 1]; \
                    p1[4 * i + 3] = __builtin_amdgcn_exp2f(p1[4 * i + 3] - x1[4 * i + 3] - a3); p1[4 * i + 2] = __builtin_amdgcn_exp2f(p1[4 * i + 2] - x1[4 * i + 2] - a2); \
                    p1[4 * i + 1] = __builtin_amdgcn_exp2f(p1[4 * i + 1] - x1[4 * i + 1] - a1); p1[4 * i + 0] = __builtin_amdgcn_exp2f(p1[4 * i + 0] - x1[4 * i + 0] - a0); \
                    ag = R2 + T1 + E0[i] + fsel * (C0[i] - S0[i]); \
                    a3 = ag; a2 = a3 + x0[4 * i + 3]; a1 = a2 + x0[4 * i + 2]; a0 = a1 + x0[4 * i + 1]; \
                    p0[4 * i + 3] = __builtin_amdgcn_exp2f(p0[4 * i + 3] - x0[4 * i + 3] - a3); p0[4 * i + 2] = __builtin_amdgcn_exp2f(p0[4 * i + 2] - x0[4 * i + 2] - a2); \
                    p0[4 * i + 1] = __builtin_amdgcn_exp2f(p0[4 * i + 1] - x0[4 * i + 1] - a1); p0[4 * i + 0] = __builtin_amdgcn_exp2f(p0[4 * i + 0] - x0[4 * i + 0] - a0); } \
                R2 += T0 + T1; \
                FA_PK4(p0, 0, pa0); FA_PK4(p0, 8, pa1); FA_PK4(p1, 0, pa2); FA_PK4(p1, 8, pa3); \
            } else { \
                if constexpr (VAR == 3) { \
                    _Pragma("unroll") for (int g = 0; g < 4; ++g) { const f32x4 b0 = *FA_LP(f32x4, L_BIAS + (BUF) * 256 + (8 * g + 4 * hi) * 4), b1 = *FA_LP(f32x4, L_BIAS + (BUF) * 256 + (32 + 8 * g + 4 * hi) * 4); \
                        _Pragma("unroll") for (int e = 0; e < 4; ++e) { p0[4 * g + e] = fmaf(p0[4 * g + e], C2, b0[e]); p1[4 * g + e] = fmaf(p1[4 * g + e], C2, b1[e]); } } \
                } \
                if (needmask) { _Pragma("unroll") for (int r = 0; r < 16; ++r) { const int c = (r & 3) + 8 * (r >> 2); \
                    if ((unsigned)(dq - c) >= (unsigned)W) p0[r] = -__builtin_inff(); if ((unsigned)(dq - c - 32) >= (unsigned)W) p1[r] = -__builtin_inff(); } } \
                float pmax = p0[0]; \
                _Pragma("unroll") for (int r = 1; r < 16; ++r) pmax = fmaxf(pmax, p0[r]); \
                _Pragma("unroll") for (int r = 0; r < 16; ++r) pmax = fmaxf(pmax, p1[r]); \
                pmax = xmax(pmax); if constexpr (VAR != 3) pmax *= C2;     \
                float alpha = 1.f; \
                if (!__all(pmax - m2 <= THR2)) { const float mn = fmaxf(m2, pmax); alpha = __builtin_amdgcn_exp2f(m2 - mn); m2 = mn; } \
                float ps = 0.f; \
                FA_EXPS(p0, 0); FA_EXPS(p0, 4); FA_EXPS(p0, 8); FA_EXPS(p0, 12);     \
                if (__any(alpha < 1.f)) { if (hi == 0) al_l[r32] = alpha; asm volatile("s_waitcnt lgkmcnt(0)" ::: "memory"); \
                    _Pragma("unroll") for (int r = 0; r < 16; ++r) { const float a_ = al_l[crow(r, hi)]; o[0][r] *= a_; o[1][r] *= a_; o[2][r] *= a_; o[3][r] *= a_; } } \
                FA_PK4(p0, 0, pa0); FA_PK4(p0, 8, pa1); \
                FA_SBAR(); FA_PV2(BUF); \
                ps = xsum(ps); l_reg = l_reg * alpha + ps; \
            } \
            if constexpr (VAR == 2) { FA_SBAR(); FA_PV(BUF); } \
        } \
        if (more) { asm volatile("s_waitcnt vmcnt(0)" ::: "memory"); FA_SWRITE((BUF) ^ 1); } \
        if constexpr (VAR == 2) wdone = wdone || __all(R2 > 64.f); \
        if constexpr (VAR == 3) { if (more) { const float bnext = (cref - __builtin_bit_cast(float, __builtin_amdgcn_readlane(__builtin_bit_cast(int, st_b), 63))) * 1.4426950408889634f; wdone = wdone || __all(qb2 + bnext - m2 < -40.f); } } \
        if constexpr (VAR == 2 || VAR == 3) { if (lane == 0) *FA_LP(int, L_FLAG + (BUF) * 32 + wid * 4) = wdone ? 1 : 0; } \
        asm volatile("s_waitcnt lgkmcnt(0)" ::: "memory"); __builtin_amdgcn_s_barrier(); asm volatile("" ::: "memory");     \
        if constexpr (VAR == 2 || VAR == 3) { int nd = 0; _Pragma("unroll") for (int w_ = 0; w_ < 8; ++w_) nd += *FA_LP(int, L_FLAG + (BUF) * 32 + w_ * 4); if (nd == 8) goto fa_done; } \
    } while (0)

    for (int jt = j_hi - 1; jt >= j_lo; jt -= 2) {
        FA_STEP(0, jt);
        if (jt - 1 < j_lo) break;
        FA_STEP(1, jt - 1);
    }
fa_done:
    {
        const int tid2 = opaque(tid); const int r32 = tid2 & 31, hi = (tid2 >> 5) & 1;
        float rli[16];
        if constexpr (VAR != 2) {
            if (hi == 0) li_l[r32] = l_reg; asm volatile("s_waitcnt lgkmcnt(0)" ::: "memory");
#pragma unroll
            for (int r = 0; r < 16; ++r) rli[r] = __builtin_amdgcn_rcpf(li_l[crow(r, hi)]);
        } else {
#pragma unroll
            for (int r = 0; r < 16; ++r) rli[r] = 1.f;
        }
        bf16* Ow = U.O + (size_t)(wid * 32) * U.op;
        { const bool odd = (r32 & 1) != 0, up2 = (r32 & 2) != 0, up4 = (r32 & 4) != 0;
#define FA_X1(x) __builtin_bit_cast(float, __builtin_amdgcn_mov_dpp(__builtin_bit_cast(int, (x)), 0xB1, 0xF, 0xF, true))
#define FA_X2(x) ((unsigned)__builtin_amdgcn_mov_dpp((int)(x), 0x4E, 0xF, 0xF, true))
#define FA_X4(x) ((unsigned)__builtin_amdgcn_mov_dpp(__builtin_amdgcn_mov_dpp((int)(x), 0x141, 0xF, 0xF, true), 0x1B, 0xF, 0xF, true))
#define FA_W8(LO, HI, r0) do { \
                const float v0 = o[d0][r0] * rli[r0], v1 = o[d0][(r0) + 1] * rli[(r0) + 1], v2 = o[d0][(r0) + 2] * rli[(r0) + 2], v3 = o[d0][(r0) + 3] * rli[(r0) + 3]; \
                const float n0 = FA_X1(v0), n1 = FA_X1(v1), n2 = FA_X1(v2), n3 = FA_X1(v3); \
                const unsigned wa = cvtpk(odd ? n1 : v0, odd ? v1 : n0), wb = cvtpk(odd ? n3 : v2, odd ? v3 : n2); \
                const unsigned got = FA_X2(up2 ? wa : wb); LO = up2 ? got : wa; HI = up2 ? wb : got; } while (0)
#pragma unroll
          for (int pr = 0; pr < 2; ++pr) { bf16* rowp = Ow + (size_t)(8 * (2 * pr + (up4 ? 1 : 0)) + 4 * hi + (r32 & 3)) * U.op + (r32 & ~7);
#pragma unroll
            for (int d0 = 0; d0 < 4; ++d0) { unsigned a_lo, a_hi, b_lo, b_hi;
                FA_W8(a_lo, a_hi, 8 * pr); FA_W8(b_lo, b_hi, 8 * pr + 4);
                const unsigned g_lo = FA_X4(up4 ? a_lo : b_lo), g_hi = FA_X4(up4 ? a_hi : b_hi);
                u32x4 w; w.x = up4 ? g_lo : a_lo; w.y = up4 ? g_hi : a_hi; w.z = up4 ? b_lo : g_lo; w.w = up4 ? b_hi : g_hi;
                *(GAS u32x4*)(rowp + d0 * 32) = w; } }
#undef FA_X1
#undef FA_X2
#undef FA_X4
#undef FA_W8
        }
        if constexpr (VAR != 2) { if (U.LSE != nullptr && hi == 0) U.LSE[(size_t)(wid * 32 + r32) * U.lp] = (m2 + __builtin_amdgcn_logf(l_reg)) * 0.6931471805599453f; }
    }
    __syncthreads();
#undef FA_SLOAD
#undef FA_SWRITE
#undef FA_TRRD
#undef FA_VRD8
#undef FA_PVMMA
#undef FA_LGKM
#undef FA_PV
#undef FA_PV2
#undef FA_VRD4
#undef FA_MMA2
#undef FA_EXPS
#undef FA_KRD
#undef FA_KPAIR
#undef FA_QKMMA
#undef FA_QKSTEP
#undef FA_QK
#undef FA_PK4
#undef FA_STEP
}
}


#ifndef FASTMASK
#define FASTMASK 15
#endif
__device__ __forceinline__ void fast_attn_phase(Frame& F, const Ptrs& P, int l, int vmask = 15) {
    LAS unsigned char* lds = F.lds + RING_OFF;
    LAS int* itemw = (LAS int*)(lds + fa::L_ITEM);
    gu32* qhead = F.ctl + CW_QUEUE + 64 * l;
    bf16* PROJ = wsb(P, WS_PROJ); bf16* O = wsb(P, WS_O);
    constexpr int N_A = 384, N_D = 256, N_C = 256, N_B = 768, N_REST = N_D + N_C + N_B;
    constexpr int CV_IN = (DM / 64) * (NP / 64) + (QLR / 64) * (NQA / 64) + 2 * (KVLR / 64) * (GW / 64), CV_GRP = (DM / 64) * (DM / 64) + (DM / 64) * (DFF / 64) + (DFF / 64) * (DM / 64), CH = 64;
    constexpr int NC_GRP = (CV_GRP + CH - 1) / CH, NC_IN = (CV_IN + CH - 1) / CH;
    const int n_conv = (vmask == 15) ? NC_GRP + ((l == 0) ? NC_IN : 0) : 0;
    const int n_pair = (n_conv < N_A + N_REST) ? n_conv : N_A + N_REST;
    const int N_ITEMS = N_A + N_REST + n_conv;
    for (;;) {
        if (F.tid == 0) *itemw = (int)__hip_atomic_fetch_add(qhead, 1u, __ATOMIC_RELAXED, __HIP_MEMORY_SCOPE_AGENT);
        __syncthreads();
        int item = __builtin_amdgcn_readfirstlane(*itemw);
        __syncthreads();
        if (item >= N_ITEMS) break;
        {
            const int j = item; int cv = -1, un;
            if (j < 2 * n_pair) { if (j & 1) cv = j >> 1; else un = j >> 1; } else { const int t = j - 2 * n_pair; if (n_conv > N_A + N_REST) cv = n_pair + t; else un = n_pair + t; }
            if (cv >= 0) {
                if (cv < NC_GRP) { const int lo_ = CV_IN + cv * CH; conv_range(F, P, l, lo_, (lo_ + CH < CV_IN + CV_GRP) ? lo_ + CH : CV_IN + CV_GRP); }
                else { const int lo_ = (cv - NC_GRP) * CH; conv_range(F, P, 1, lo_, (lo_ + CH < CV_IN) ? lo_ + CH : CV_IN); }
                continue; }
            item = un;
        }
        fa::UnitRef U; U.KR = nullptr; U.CK = nullptr; U.COS = nullptr; U.SIN = nullptr; U.LSE = nullptr; U.lp = 0; U.kn2 = 0.f;
        if (item < N_A) {
            if (!(FASTMASK & 1) || !(vmask & 1)) continue;
            const int a = item >> 3, h = item & 7, k = a / 3, j = a - 3 * k;
            const int qb = (j < 2) ? 31 - k : 15 - k;
            U.Q = wsb(P, WS_QA) + (size_t)(qb * 256) * NQA + h * 192; U.qp = NQA; U.K = wsb(P, WS_KVU) + h * HD; U.kp = NKVU; U.V = wsb(P, WS_KVU) + GW + h * HD; U.vp = NKVU;
            U.KR = wsb(P, WS_KR); U.COS = wsf(P, WS_COS64); U.SIN = wsf(P, WS_SIN64); U.P0 = qb * 256;
            if (j < 2) { U.jlo = j * 2 * (qb + 1); U.jhi = (j + 1) * 2 * (qb + 1);
                U.O = wsb(P, WS_PA) + (size_t)j * S * GW + (size_t)(qb * 256) * GW + h * HD; U.op = GW; U.LSE = wsf(P, WS_LSEA) + (size_t)j * S * NH + (size_t)(qb * 256) * NH + h; U.lp = NH; }
            else { U.jlo = 0; U.jhi = 4 * (qb + 1); U.O = O + (size_t)(qb * 256) * DM + h * HD; U.op = DM; }
            fa::attn_unit<0>(lds, U, opaque(F.tid));
        } else if (item < N_A + N_D) {
            if (!(FASTMASK & 8) || !(vmask & 8)) continue;
            const int i = item - N_A, qb = 31 - (i >> 3), h = i & 7;
            U.Q = PROJ + (size_t)(qb * 256) * NP + PC_D + h * HD; U.qp = NP; U.K = PROJ + PC_D + GW + h * HD; U.kp = NP; U.V = PROJ + PC_D + 2 * GW + h * HD; U.vp = NP;
            U.CK = wsf(P, WS_CK) + (size_t)h * S; U.O = O + (size_t)(qb * 256) * DM + 3 * GW + h * HD; U.op = DM; U.P0 = qb * 256; U.jlo = 0; U.jhi = 4 * (qb + 1);
            U.kn2 = __builtin_bit_cast(float, __hip_atomic_load(F.ctl + CW_KN + 16 * (l & 1) + h, __ATOMIC_RELAXED, __HIP_MEMORY_SCOPE_AGENT));
            fa::attn_unit<3>(lds, U, opaque(F.tid));
        } else if (item < N_A + N_D + N_C) {
            if (!(FASTMASK & 4) || !(vmask & 4)) continue;
            const int i = item - N_A - N_D, qb = 31 - (i >> 3), h = i & 7;
            U.Q = PROJ + (size_t)(qb * 256) * NP + PC_C + h * HD; U.qp = NP; U.K = PROJ + PC_C + GW + h * HD; U.kp = NP; U.V = PROJ + PC_C + 2 * GW + h * HD; U.vp = NP;
            U.O = O + (size_t)(qb * 256) * DM + 2 * GW + h * HD; U.op = DM; U.P0 = qb * 256; U.jlo = 0; U.jhi = 4 * (qb + 1);
            fa::attn_unit<2>(lds, U, opaque(F.tid));
        } else {
            if (!(FASTMASK & 2) || !(vmask & 2)) continue;
            const int i = item - N_A - N_D - N_C, br = i >> 8, rest = i & 255, h = rest & 7, blk = rest >> 3;
            const int dil = (br == 0) ? 1 : (br == 1) ? 4 : 16; const int nbr = (S / dil) / 256; const int res = blk / nbr, bi = blk - res * nbr;
            const size_t tok0 = (size_t)res + (size_t)dil * (bi * 256);
            U.Q = PROJ + tok0 * NP + PC_B + h * HD; U.qp = dil * NP; U.K = PROJ + (size_t)res * NP + PC_B + GW + h * HD; U.kp = dil * NP; U.V = PROJ + (size_t)res * NP + PC_B + 2 * GW + h * HD; U.vp = dil * NP;
            U.O = wsb(P, WS_OB) + (size_t)br * S * GW + tok0 * GW + h * HD; U.op = dil * GW; U.LSE = wsf(P, WS_LSE) + (size_t)br * S * NH + tok0 * NH + h; U.lp = dil * NH; U.P0 = bi * 256;
            U.jlo = (bi * 256 - 128 > 0) ? (bi * 256 - 128) / 64 : 0; U.jhi = 4 * (bi + 1);
            fa::attn_unit<1>(lds, U, opaque(F.tid));
        }
    }
}

__device__ __forceinline__ void slow_attn_task(const Ptrs& P, int var, int h, int t, int lane) {
    const bf16* PROJ = wsb(P, WS_PROJ); bf16* O = wsb(P, WS_O);
    const bf16 *qp, *kbase, *vbase; int kp;
    float scale = 0.08838834764831845f;
    float qr_ = 0.f;
    const bf16* krb = wsb(P, WS_KR);
    if (var == 0) { qp = wsb(P, WS_QA) + (size_t)t * NQA + h * 192; kbase = wsb(P, WS_KVU) + h * HD; vbase = wsb(P, WS_KVU) + GW + h * HD; kp = NKVU; scale = 0.07216878364870323f;
        const float mine = bf2f(qp[128 + lane]); const float other = __shfl_xor(mine, 32);
        const float c = wsf(P, WS_COS64)[t * 32 + (lane & 31)], sn = wsf(P, WS_SIN64)[t * 32 + (lane & 31)];
        qr_ = (lane < 32) ? (mine * c - other * sn) : (other * sn + mine * c);
        qr_ = bf2f((bf16)f2bf(qr_)); }
    else { const int pc = (var == 1) ? PC_B : (var == 2) ? PC_C : PC_D; qp = PROJ + (size_t)t * NP + pc + h * HD; kbase = PROJ + pc + GW + h * HD; vbase = PROJ + pc + 2 * GW + h * HD; kp = NP; }
    const unsigned qw = *(const GAS unsigned*)(qp + 2 * lane); const float q0 = bflo(qw), q1 = bfhi(qw);
    float o0 = 0.f, o1 = 0.f;
    if (var == 2) {
        float R = 0.f;
        for (int s0 = t - 1; s0 >= 0; s0 -= 4) {
            float part[4]; unsigned vw[4];
#pragma unroll
            for (int i = 0; i < 4; ++i) { const int s = s0 - i; const int sc = s < 0 ? 0 : s; const unsigned kw = *(const GAS unsigned*)(kbase + (size_t)sc * kp + 2 * lane); vw[i] = *(const GAS unsigned*)(vbase + (size_t)sc * kp + 2 * lane);
                part[i] = q0 * bflo(kw) + q1 * bfhi(kw); }
#pragma unroll
            for (int i = 0; i < 4; ++i) part[i] = wave_sum(part[i]);
#pragma unroll
            for (int i = 0; i < 4; ++i) { if (s0 - i >= 0) { const float z = part[i] * scale; const float sp = fmaxf(z, 0.f) + log1pf(expf(-fabsf(z))); const float a = expf(z - sp - R); R += sp; o0 += a * bflo(vw[i]); o1 += a * bfhi(vw[i]); } }
            if (R > 100.f) break;
        }
    } else {
        float m = -1e30f, lsum = 0.f;
        const float* CK = wsf(P, WS_CK) + (size_t)h * S; const float cq = (var == 3) ? CK[t] : 0.f;
        const int nbr = (var == 1) ? 3 : 1;
        for (int br = 0; br < nbr; ++br) {
            const int dil = (var == 1) ? (br == 0 ? 1 : br == 1 ? 4 : 16) : 1; const int nk = (var == 1) ? 129 : t + 1;
            for (int j0 = 0; j0 < nk; j0 += 4) {
                float part[4]; unsigned vw[4]; float bias[4]; bool ok[4];
#pragma unroll
                for (int i = 0; i < 4; ++i) { const int j = j0 + i; const int s = t - dil * j; ok[i] = (j < nk) && (s >= 0); const int sc = ok[i] ? s : 0;
                    const unsigned kw = *(const GAS unsigned*)(kbase + (size_t)sc * kp + 2 * lane); vw[i] = *(const GAS unsigned*)(vbase + (size_t)sc * kp + 2 * lane);
                    part[i] = q0 * bflo(kw) + q1 * bfhi(kw);
                    if (var == 0) part[i] += qr_ * bf2f(krb[(size_t)sc * 64 + lane]);
                    bias[i] = (var == 3) ? (cq - CK[sc]) : 0.f; }
#pragma unroll
                for (int i = 0; i < 4; ++i) part[i] = wave_sum(part[i]);
                float sc4[4]; float mx = m;
#pragma unroll
                for (int i = 0; i < 4; ++i) { sc4[i] = ok[i] ? part[i] * scale + bias[i] : -__builtin_inff(); mx = fmaxf(mx, sc4[i]); }
                const float alpha = expf(m - mx); lsum *= alpha; o0 *= alpha; o1 *= alpha; m = mx;
#pragma unroll
                for (int i = 0; i < 4; ++i) { const float p = expf(sc4[i] - mx); lsum += p; o0 += p * bflo(vw[i]); o1 += p * bfhi(vw[i]); }
            }
        }
        o0 /= lsum; o1 /= lsum;
    }
    *(GAS unsigned*)(O + (size_t)t * DM + var * GW + h * HD + 2 * lane) = pk2(o0, o1);
}
__device__ __forceinline__ void slow_attn_phase(Frame& F, const Ptrs& P) {
    const int gw = blockIdx.x * NWAVES + F.wave, NGW = F.G * NWAVES;
    for (int k = 0; (size_t)k * NGW + gw < (size_t)S * 32; ++k) {
        const int n = k * NGW + gw; const int t = n >> 5; const int hv = (gw + k) & 31;
        if ((FASTMASK >> (hv & 3)) & 1) continue;
        slow_attn_task(P, hv & 3, hv >> 2, t, F.lane);
    }
}

__device__ __forceinline__ void groupnorm_rows(Frame& F, const Ptrs& P, int l) {
    const int gw = blockIdx.x * NWAVES + F.wave, NGW = F.G * NWAVES, lane = F.lane;
    const bf16* O = wsb(P, WS_O); bf16* ON = wsb(P, WS_H); const float* go = P.g_out + (size_t)l * DM;
    for (int m = gw; m < S; m += NGW) {
#pragma unroll
        for (int g = 0; g < 4; ++g) {
            float f[16]; float s = 0.f;
#pragma unroll
            for (int c = 0; c < 2; ++c) {
                if ((FASTMASK & 2) && g == 1) {
                    const int hh = c * 4 + (lane >> 4); const float* L = wsf(P, WS_LSE) + (size_t)m * NH + hh;
                    const float l0 = L[0], l1 = L[(size_t)S * NH], l2 = L[(size_t)2 * S * NH]; const float mx = fmaxf(l0, fmaxf(l1, l2));
                    float w0 = expf(l0 - mx), w1 = expf(l1 - mx), w2 = expf(l2 - mx); const float inv = 1.f / (w0 + w1 + w2); w0 *= inv; w1 *= inv; w2 *= inv;
                    const bf16* ob = wsb(P, WS_OB) + (size_t)m * GW + c * 512 + 8 * lane;
                    const v4u a = *(const GAS v4u*)ob, b = *(const GAS v4u*)(ob + (size_t)S * GW), d = *(const GAS v4u*)(ob + (size_t)2 * S * GW);
                    f[8 * c + 0] = w0 * bflo(a.x) + w1 * bflo(b.x) + w2 * bflo(d.x); f[8 * c + 1] = w0 * bfhi(a.x) + w1 * bfhi(b.x) + w2 * bfhi(d.x);
                    f[8 * c + 2] = w0 * bflo(a.y) + w1 * bflo(b.y) + w2 * bflo(d.y); f[8 * c + 3] = w0 * bfhi(a.y) + w1 * bfhi(b.y) + w2 * bfhi(d.y);
                    f[8 * c + 4] = w0 * bflo(a.z) + w1 * bflo(b.z) + w2 * bflo(d.z); f[8 * c + 5] = w0 * bfhi(a.z) + w1 * bfhi(b.z) + w2 * bfhi(d.z);
                    f[8 * c + 6] = w0 * bflo(a.w) + w1 * bflo(b.w) + w2 * bflo(d.w); f[8 * c + 7] = w0 * bfhi(a.w) + w1 * bfhi(b.w) + w2 * bfhi(d.w);
                    continue; }
                if ((FASTMASK & 1) && g == 0 && m >= S / 2) {
                    const int hh = c * 4 + (lane >> 4); const float* L = wsf(P, WS_LSEA) + (size_t)m * NH + hh;
                    const float l0 = L[0], l1 = L[(size_t)S * NH]; const float mx = fmaxf(l0, l1);
                    float w0 = expf(l0 - mx), w1 = expf(l1 - mx); const float inv = 1.f / (w0 + w1); w0 *= inv; w1 *= inv;
                    const bf16* ob = wsb(P, WS_PA) + (size_t)m * GW + c * 512 + 8 * lane;
                    const v4u a = *(const GAS v4u*)ob, b = *(const GAS v4u*)(ob + (size_t)S * GW);
                    f[8 * c + 0] = w0 * bflo(a.x) + w1 * bflo(b.x); f[8 * c + 1] = w0 * bfhi(a.x) + w1 * bfhi(b.x); f[8 * c + 2] = w0 * bflo(a.y) + w1 * bflo(b.y); f[8 * c + 3] = w0 * bfhi(a.y) + w1 * bfhi(b.y);
                    f[8 * c + 4] = w0 * bflo(a.z) + w1 * bflo(b.z); f[8 * c + 5] = w0 * bfhi(a.z) + w1 * bfhi(b.z); f[8 * c + 6] = w0 * bflo(a.w) + w1 * bflo(b.w); f[8 * c + 7] = w0 * bfhi(a.w) + w1 * bfhi(b.w);
                    continue; }
                const v4u w = *(const GAS v4u*)(O + (size_t)m * DM + g * GW + c * 512 + 8 * lane);
                f[8 * c + 0] = bflo(w.x); f[8 * c + 1] = bfhi(w.x); f[8 * c + 2] = bflo(w.y); f[8 * c + 3] = bfhi(w.y); f[8 * c + 4] = bflo(w.z); f[8 * c + 5] = bfhi(w.z); f[8 * c + 6] = bflo(w.w); f[8 * c + 7] = bfhi(w.w); }
#pragma unroll
            for (int e = 0; e < 16; ++e) s += f[e] * f[e];
            const float rstd = 1.f / sqrtf(wave_sum(s) * (1.f / GW) + EPS);
#pragma unroll
            for (int c = 0; c < 2; ++c) { const float* g8 = go + g * GW + c * 512 + 8 * lane; v4u o;
                o.x = pk2(f[8 * c + 0] * rstd * g8[0], f[8 * c + 1] * rstd * g8[1]); o.y = pk2(f[8 * c + 2] * rstd * g8[2], f[8 * c + 3] * rstd * g8[3]);
                o.z = pk2(f[8 * c + 4] * rstd * g8[4], f[8 * c + 5] * rstd * g8[5]); o.w = pk2(f[8 * c + 6] * rstd * g8[6], f[8 * c + 7] * rstd * g8[7]);
                *(GAS v4u*)(ON + (size_t)m * DM + g * GW + c * 512 + 8 * lane) = o; }
        }
    }
}

#ifndef DUP
#define DUP 0
#endif
#ifndef DUPV
#define DUPV 15
#endif
#ifndef MK_N_LAUNCHES
#define MK_N_LAUNCHES 1
#endif
constexpr int N_PHASES = 22;
struct Args { const float* in[15]; float* out; unsigned char* ws; int ph_lo, ph_hi; };
__global__ void __launch_bounds__(NWAVES * 64, 2) fwd_kernel(Args args) {
    extern __shared__ __attribute__((aligned(16))) unsigned char lds[];
    Frame F;
    F.lds = (LAS unsigned char*)lds;
    F.MISC = (volatile LAS unsigned*)(F.lds + MISC_OFF);
    F.tid = threadIdx.x; F.lane = 0; F.wave = 0;
    F.G = gridDim.x;
    F.ctl = (gu32*)(args.ws + WS_CTL);
    Ptrs P;
    P.x = args.in[0]; P.g_attn = args.in[1]; P.w_in = args.in[2]; P.g_q = args.in[3]; P.g_kv = args.in[4]; P.w_uq = args.in[5]; P.w_uk = args.in[6]; P.w_uv = args.in[7];
    P.b_f = args.in[8]; P.g_out = args.in[9]; P.w_o = args.in[10]; P.g_mlp = args.in[11]; P.w_up = args.in[12]; P.w_down = args.in[13]; P.g_final = args.in[14];
    P.out = args.out; P.ws = args.ws;
    for (int u = F.tid; u < (LDS_BYTES - LDSCTL_OFF) / 4; u += NWAVES * 64) ((LAS unsigned*)(F.lds + LDSCTL_OFF))[u] = 0u;
    __syncthreads();
    XcdBarrier bar; bar.bar = (unsigned*)(F.ctl + CW_BAR); bar.x = 0; bar.st = nullptr;
    if (MK_N_LAUNCHES == 1) bar = xcd_barrier_post((unsigned*)(F.ctl + CW_BAR), F.MISC + 8);
    const int lo = args.ph_lo, hi = args.ph_hi;
#define IN(k) (lo <= (k) && (k) < hi)
#define SEAM(k) do { if (IN(k) && IN((k) + 1)) xcd_barrier(bar); } while (0)

    if (IN(0)) { LFRAME; p0_prologue(Fl, P, 0, 0); } SEAM(0);
    for (int l = 0; l < 2; ++l) {
        const int pb = 1 + 10 * l; const size_t wb = WS_W0 + (size_t)l * WS_WSTRIDE;
        if (false) { LFRAME; p0_prologue(Fl, P, 1, 0); xcd_barrier(bar); }
        const float* xin = (l == 0) ? P.x : wsf(P, WS_X1);
        if (IN(pb + 1)) {
            pg8::Gemm g{wsb(P, WS_XB), wsb(P, wb + WO_IN), S, NMAIN, DM, DM, DM}; pg8::StaticOrder So; So.init(S, NMAIN, F.G, (int)blockIdx.x);
            pg8::EpiBf16<0> E{wsb(P, WS_PROJ), NP, wsf(P, WS_PF), PC_F, (const float*)(F.ctl + CW_SS) + (size_t)(2 * l) * S, 1.f / DM, wsb(P, WS_H), DM, 6, wsf(P, WS_CQ), 11, nullptr, 0, 0};
            pg8::gemm_phase<pg8::EpiBf16<0>, pg8::StaticOrder, true, true>(F.lds + RING_OFF, g, So, E);
        } SEAM(pb + 1);
        if (IN(pb + 2)) {
            const size_t w2 = WS_WUP2 + (size_t)l * 28 * MiB;
            pg8::Gemm g{wsb(P, WS_XB), wsb(P, wb + WO_IN), S, NP, DM, DM, DM, wsb(P, WS_H) + PC_CQ, wsb(P, w2), QLR, wsb(P, WS_H) + PC_CKV, wsb(P, w2 + 12 * MiB), KVLR};
            pg8::MixOrder Sm{F.G, (int)blockIdx.x, NMAIN / 256};
            pg8::EpiMix E{ {wsb(P, WS_PROJ), NP, nullptr, 0, (const float*)(F.ctl + CW_SS) + (size_t)(2 * l) * S, 1.f / DM, nullptr, 0, 0, nullptr, 0, nullptr, 0, 0},
                           {wsb(P, WS_QA), NQA, nullptr, 0, nullptr, 1.f / QLR, nullptr, 0, 0, nullptr, 0, wsf(P, WS_CQ), 0, 28},
                           {wsb(P, WS_KVU), NKVU, nullptr, 0, nullptr, 1.f / KVLR, nullptr, 0, 0, nullptr, 0, wsf(P, WS_CQ), 28, 16} };
            pg8::gemm_phase<pg8::EpiMix, pg8::MixOrder, true, true>(F.lds + RING_OFF, g, Sm, E);
            { const int b0 = (F.G == 256) ? 64 : 0, nb_ = F.G - b0;
              if ((int)blockIdx.x >= b0) { LFRAME; if ((int)blockIdx.x - b0 < NH) cumsum_head(Fl, P, (int)blockIdx.x - b0, l); postproj_rows(Fl, P, l, b0, nb_); } }
        } SEAM(pb + 2);
        if (IN(pb + 4)) { LFRAME; if (FASTMASK != 0) fast_attn_phase(Fl, P, l); if (FASTMASK != 15) slow_attn_phase(Fl, P); if (DUP & 2) { xcd_barrier(bar); fast_attn_phase(Fl, P, l + 2, DUPV); } } SEAM(pb + 4);
        if (IN(pb + 5)) { LFRAME; groupnorm_rows(Fl, P, l);     if (DUP & 4) { xcd_barrier(bar); groupnorm_rows(Fl, P, l); } } SEAM(pb + 5);
        if (IN(pb + 6)) {
            pg8::Gemm g{wsb(P, WS_H), wsb(P, wb + WO_O), S, DM, DM, DM, DM}; pg8::StaticOrder So; So.init(S, DM, F.G, (int)blockIdx.x);
            pg8::EpiResid E{xin, wsf(P, WS_X1), DM, wsb(P, WS_XB), (float*)(F.ctl + CW_SS) + (size_t)(2 * l + 1) * S};
            pg8::gemm_phase<pg8::EpiResid, pg8::StaticOrder, true, true>(F.lds + RING_OFF, g, So, E);
        } SEAM(pb + 6);
        if (IN(pb + 8)) {
            pg8::Gemm g{wsb(P, WS_XB), wsb(P, wb + WO_UP), S, DFF, DM, DM, DM}; pg8::StaticOrder So; So.init(S, DFF, F.G, (int)blockIdx.x);
            pg8::EpiBf16<2> E{wsb(P, WS_U), DFF, nullptr, 0, (const float*)(F.ctl + CW_SS) + (size_t)(2 * l + 1) * S, 1.f / DM};
            pg8::gemm_phase<pg8::EpiBf16<2>, pg8::StaticOrder, true, true>(F.lds + RING_OFF, g, So, E);
        } SEAM(pb + 8);
        if (IN(pb + 9)) {
            pg8::Gemm g{wsb(P, WS_U), wsb(P, wb + WO_DN), S, DM, DFF, DFF, DFF}; pg8::StaticOrder So; So.init(S, DM, F.G, (int)blockIdx.x);
            pg8::EpiResid E{wsf(P, WS_X1), wsf(P, WS_X1), DM, (l == 0) ? wsb(P, WS_XB) : (bf16*)nullptr, (float*)(F.ctl + CW_SS) + (size_t)(2 * l + 2) * S};
            pg8::gemm_phase<pg8::EpiResid, pg8::StaticOrder, true, true>(F.lds + RING_OFF, g, So, E);
        } SEAM(pb + 9);
    }
    if (IN(21)) { LFRAME; rms_rows<true>(Fl, wsf(P, WS_X1), P.g_final, nullptr, P.out); if (DUP & 4) { xcd_barrier(bar); rms_rows<true>(Fl, wsf(P, WS_X1), P.g_final, nullptr, P.out); } }
#undef IN
#undef SEAM
}

extern "C" void kernel_launch(void* const* d_in, const int* in_sizes, int n_in, void* d_out, int out_size, void* d_ws, size_t ws_size, hipStream_t stream) {
    static int grid = 0;
    if (grid == 0) {
        if (n_in != 15 || out_size != S * DM || ws_size < WS_END) { fprintf(stderr, "kernel_launch: unexpected shapes (n_in %d out %d ws %zu, need %zu)\n", n_in, out_size, ws_size, (size_t)WS_END); grid = -1; return; }
        int dev = 0, cus = 0, per_cu = 0;
        if (hipGetDevice(&dev) != hipSuccess || hipDeviceGetAttribute(&cus, hipDeviceAttributeMultiprocessorCount, dev) != hipSuccess) { grid = -1; return; }
        if (hipFuncSetAttribute((const void*)fwd_kernel, hipFuncAttributeMaxDynamicSharedMemorySize, LDS_BYTES) != hipSuccess) { fprintf(stderr, "kernel_launch: hipFuncSetAttribute failed\n"); grid = -1; return; }
        if (hipOccupancyMaxActiveBlocksPerMultiprocessor(&per_cu, (const void*)fwd_kernel, NWAVES * 64, LDS_BYTES) != hipSuccess || per_cu < 1) fprintf(stderr, "kernel_launch: occupancy query says %d\n", per_cu);
        (void)hipGetLastError();
        grid = cus;
    }
    if (grid < 0) return;
    if (hipMemsetAsync((char*)d_ws + WS_CTL, 0, CTL_ZERO_BYTES, stream) != hipSuccess) return;
    Args a{};
    for (int i = 0; i < 15; ++i) a.in[i] = (const float*)d_in[i];
    a.out = (float*)d_out; a.ws = (unsigned char*)d_ws;
    if (MK_N_LAUNCHES == 1) { a.ph_lo = 0; a.ph_hi = N_PHASES; hipLaunchKernelGGL(fwd_kernel, dim3(grid), dim3(NWAVES * 64), LDS_BYTES, stream, a); }
    else { for (int p = 0; p < N_PHASES; ++p) { a.ph_lo = p; a.ph_hi = p + 1; hipLaunchKernelGGL(fwd_kernel, dim3(grid), dim3(NWAVES * 64), LDS_BYTES, stream, a); } }
}
```
